# Optimizing an MI355X kernel written in HIP

```python
import math
import jax, jax.numpy as jnp
from jax import lax
import numpy as np

D_MODEL = 2048
BATCH = 4
SEQ = 2048
DEPTH = 2

F32 = jnp.float32
N_META = 16
CHUNK = 64
LN_EPS = 1e-5
S5_WIDTH = D_MODEL // 2
S5_GROUP = 16
S5_GROUPS = S5_WIDTH // S5_GROUP
S5_STATE = 64
GLA_HEADS = 4
GLA_DK = D_MODEL // 16
GLA_DV = D_MODEL // 8
GLA_QK = GLA_HEADS * GLA_DK
GLA_WIDTH = GLA_HEADS * GLA_DV
GLA_RANK = 16
GLA_TAU = 16.0
RET_HEADS = 8
RET_DK = D_MODEL // RET_HEADS
RET_DV = 2 * RET_DK
RET_QK = RET_HEADS * RET_DK
RET_WIDTH = RET_HEADS * RET_DV
ROPE_BASE = 10000.0
AB_SPLITS = (S5_WIDTH, S5_WIDTH + GLA_QK, S5_WIDTH + 2 * GLA_QK, S5_WIDTH + 2 * GLA_QK + GLA_WIDTH,
             S5_WIDTH + 2 * GLA_QK + 2 * GLA_WIDTH)
AB_COLS = S5_WIDTH + 2 * GLA_QK + 2 * GLA_WIDTH + GLA_RANK
RET_SPLITS = (RET_QK, 2 * RET_QK, 2 * RET_QK + RET_WIDTH)
RET_COLS = 2 * RET_QK + 2 * RET_WIDTH
N_EXPERTS = 64
TOP_K = 8
N_GROUPS = 8
TOPK_GROUPS = 4
D_EXPERT = D_MODEL // 4
ROUTE_SCALE = 2.5
MOE_BLOCK = 128
DEEPNORM_ALPHA = (2 * DEPTH) ** 0.25
DEEPNORM_BETA = (8 * DEPTH) ** -0.25
N_EVEN = (DEPTH + 1) // 2
N_ODD = DEPTH // 2

kernel_name = "hybrid_s5_gla_retnet_moe_deepnorm"


def layer_norm(x, g, b):
    xf = x.astype(F32)
    mu = xf.mean(-1, keepdims=True)
    var = jnp.square(xf - mu).mean(-1, keepdims=True)
    return ((xf - mu) * lax.rsqrt(var + LN_EPS) * g.astype(F32) + b.astype(F32)).astype(x.dtype)


def head_norm(o, g):
    Bsz, L, H, dv = o.shape
    of = o.astype(F32)
    mu = of.mean(-1, keepdims=True)
    var = jnp.square(of - mu).mean(-1, keepdims=True)
    y = (of - mu) * lax.rsqrt(var + LN_EPS)
    return y.reshape(Bsz, L, H * dv) * g.astype(F32)


def to_chunks(t):
    Bsz, L, H, d = t.shape
    pad = (-L) % CHUNK
    t = jnp.pad(t, ((0, 0), (pad, 0), (0, 0), (0, 0)))
    return t.reshape(Bsz, (L + pad) // CHUNK, CHUNK, H, d).transpose(0, 3, 1, 2, 4)


def from_chunks(t, L):
    Bsz, H, N, C, d = t.shape
    t = t.transpose(0, 2, 3, 1, 4).reshape(Bsz, N * C, H, d)
    return t[:, N * C - L:]


def chunk_state_scan(q_in, k_in, v, state_decay):
    Bsz, H, N, C, dk = q_in.shape
    dv = v.shape[-1]

    def step(S, inp):
        qc, kc, vc, dc = inp
        o = jnp.einsum('bhcd,bhdv->bhcv', qc, S)
        S = S * dc[..., None] + jnp.einsum('bhcd,bhcv->bhdv', kc, vc)
        return S, o

    xs = tuple(jnp.moveaxis(t, 2, 0) for t in (q_in, k_in, v, state_decay))
    _, o = lax.scan(step, jnp.zeros((Bsz, H, dk, dv), F32), xs)
    return jnp.moveaxis(o, 0, 2)


def gla_chunked(q, k, v, g):
    b = jnp.cumsum(g, axis=3)
    b_last = b[:, :, :, -1:, :]
    q_in = q * jnp.exp(b)
    causal = jnp.tril(jnp.ones((CHUNK, CHUNK), F32))
    scores = jnp.einsum('bhnid,bhnjd->bhnij', q_in, k * jnp.exp(-b)) * causal
    o_intra = jnp.einsum('bhnij,bhnjv->bhniv', scores, v)
    o_inter = chunk_state_scan(q_in, k * jnp.exp(b_last - b), v, jnp.exp(b_last[:, :, :, 0, :]))
    return o_intra + o_inter


def retention_chunked(q, k, v):
    Bsz, H, N, C, dk = q.shape
    log_gamma = jnp.log(1.0 - 2.0 ** (-5.0 - jnp.arange(H, dtype=F32)))
    pos = jnp.arange(C, dtype=F32)
    diff = pos[:, None] - pos[None, :]
    dmask = jnp.where(diff >= 0, jnp.exp(log_gamma[:, None, None] * jnp.maximum(diff, 0.0)), 0.0)
    xi = jnp.exp(log_gamma[:, None] * (pos + 1.0))
    zeta = jnp.exp(log_gamma[:, None] * (C - 1.0 - pos))
    chunk_decay = jnp.exp(log_gamma * C)
    scores = jnp.einsum('bhnid,bhnjd->bhnij', q, k) * dmask[:, None]
    o_intra = jnp.einsum('bhnij,bhnjv->bhniv', scores, v)
    decay = jnp.broadcast_to(chunk_decay[None, :, None, None], (Bsz, H, N, dk))
    o_inter = chunk_state_scan(q * xi[:, None, :, None], k * zeta[:, None, :, None], v, decay)
    return o_intra + o_inter


def rotary(t):
    L, d = t.shape[1], t.shape[-1]
    inv = ROPE_BASE ** (-jnp.arange(0, d, 2, dtype=F32) / d)
    ang = jnp.arange(L, dtype=F32)[:, None] * inv[None, :]
    cos = jnp.cos(ang)[None, :, None, :]
    sin = jnp.sin(ang)[None, :, None, :]
    tf = t.astype(F32)
    t1, t2 = tf[..., : d // 2], tf[..., d // 2:]
    return jnp.concatenate([t1 * cos - t2 * sin, t1 * sin + t2 * cos], axis=-1)


def s5_mixer(u, log_dt, lam_re, lam_im, b_re, b_im, c_re, c_im, d, w_glu):
    Bsz, L, _ = u.shape
    uf = u.astype(F32)
    ug = uf.reshape(Bsz, L, S5_GROUPS, S5_GROUP)
    dt = jnp.exp(log_dt.astype(F32))[:, None]
    lr, li = lam_re.astype(F32), lam_im.astype(F32)
    mag = jnp.exp(lr * dt)
    ab_re, ab_im = mag * jnp.cos(li * dt), mag * jnp.sin(li * dt)
    den = lr * lr + li * li
    nr, ni = ab_re - 1.0, ab_im
    z_re = (nr * lr + ni * li) / den
    z_im = (ni * lr - nr * li) / den
    bu_re = jnp.einsum('blgc,gpc->blgp', ug, b_re.astype(F32))
    bu_im = jnp.einsum('blgc,gpc->blgp', ug, b_im.astype(F32))
    e_re = z_re * bu_re - z_im * bu_im
    e_im = z_re * bu_im + z_im * bu_re
    a_re = jnp.broadcast_to(ab_re, e_re.shape)
    a_im = jnp.broadcast_to(ab_im, e_im.shape)

    def combine(left, right):
        a1r, a1i, b1r, b1i = left
        a2r, a2i, b2r, b2i = right
        return (a2r * a1r - a2i * a1i, a2r * a1i + a2i * a1r,
                a2r * b1r - a2i * b1i + b2r, a2r * b1i + a2i * b1r + b2i)

    _, _, h_re, h_im = lax.associative_scan(combine, (a_re, a_im, e_re, e_im), axis=1)
    y = (jnp.einsum('blgp,gcp->blgc', h_re, c_re.astype(F32))
         - jnp.einsum('blgp,gcp->blgc', h_im, c_im.astype(F32)))
    y = y.reshape(Bsz, L, S5_WIDTH) + d.astype(F32) * uf
    z = jax.nn.gelu(y)
    return (z * jax.nn.sigmoid(z @ w_glu.astype(F32))).astype(u.dtype)


def ab_mixer(h, w_in, log_dt, lam_re, lam_im, b_re, b_im, c_re, c_im, d, w_glu,
             gla_w_gate2, gla_b_gate, gla_norm_g, w_out):
    Bsz, L, _ = h.shape
    proj = h @ w_in
    u, q, k, v, r, gl = jnp.split(proj, AB_SPLITS, axis=-1)
    y_a = s5_mixer(u, log_dt, lam_re, lam_im, b_re, b_im, c_re, c_im, d, w_glu)
    q = q.astype(F32).reshape(Bsz, L, GLA_HEADS, GLA_DK) * (GLA_DK ** -0.5)
    k = k.astype(F32).reshape(Bsz, L, GLA_HEADS, GLA_DK)
    v = v.astype(F32).reshape(Bsz, L, GLA_HEADS, GLA_DV)
    g = jax.nn.log_sigmoid((gl @ gla_w_gate2 + gla_b_gate).astype(F32)) / GLA_TAU
    g = g.reshape(Bsz, L, GLA_HEADS, GLA_DK)
    o = gla_chunked(to_chunks(q), to_chunks(k), to_chunks(v), to_chunks(g))
    o = head_norm(from_chunks(o, L), gla_norm_g) * jax.nn.silu(r.astype(F32))
    mixed = jnp.concatenate([y_a.astype(F32), o], axis=-1).astype(h.dtype)
    return mixed @ w_out


def retention_mixer(h, w_in, norm_g, w_out):
    Bsz, L, _ = h.shape
    proj = h @ w_in
    q, k, v, gt = jnp.split(proj, RET_SPLITS, axis=-1)
    q = rotary(q.reshape(Bsz, L, RET_HEADS, RET_DK))
    k = rotary(k.reshape(Bsz, L, RET_HEADS, RET_DK)) * (RET_DK ** -0.5)
    v = v.astype(F32).reshape(Bsz, L, RET_HEADS, RET_DV)
    o = retention_chunked(to_chunks(q), to_chunks(k), to_chunks(v))
    o = head_norm(from_chunks(o, L), norm_g) * jax.nn.silu(gt.astype(F32))
    return o.astype(h.dtype) @ w_out


def moe(h, router, bias, w_gate, w_up, w_down, s_gate, s_up, s_down):
    Bsz, L, D = h.shape
    T = Bsz * L
    xt = h.reshape(T, D)
    s = jax.nn.sigmoid((xt @ router).astype(F32))
    sb = s + bias.astype(F32)
    grp_score = lax.top_k(sb.reshape(T, N_GROUPS, N_EXPERTS // N_GROUPS), 2)[0].sum(-1)
    _, gidx = lax.top_k(grp_score, TOPK_GROUPS)
    gmask = (gidx[:, :, None] == jnp.arange(N_GROUPS)[None, None, :]).any(axis=1)
    emask = jnp.repeat(gmask, N_EXPERTS // N_GROUPS, axis=1)
    _, idx = lax.top_k(jnp.where(emask, sb, -jnp.inf), TOP_K)
    wsel = jnp.take_along_axis(s, idx, axis=1)
    wsel = wsel / wsel.sum(-1, keepdims=True) * ROUTE_SCALE
    n_assign = T * TOP_K
    n_blocks = -(-n_assign // MOE_BLOCK) + N_EXPERTS
    flat_e = idx.reshape(-1)
    flat_t = jnp.repeat(jnp.arange(T, dtype=jnp.int32), TOP_K)
    flat_w = wsel.reshape(-1)
    order = jnp.argsort(flat_e)
    se, st, sw = flat_e[order], flat_t[order], flat_w[order]
    counts = jnp.bincount(flat_e, length=N_EXPERTS)
    starts = jnp.cumsum(counts) - counts
    padded = ((counts + MOE_BLOCK - 1) // MOE_BLOCK) * MOE_BLOCK
    pend = jnp.cumsum(padded)
    dest = (pend - padded)[se] + (jnp.arange(n_assign) - starts[se])
    buf_tok = jnp.zeros((n_blocks * MOE_BLOCK,), jnp.int32).at[dest].set(st)
    buf_w = jnp.zeros((n_blocks * MOE_BLOCK,), F32).at[dest].set(sw)
    block_e = jnp.minimum(jnp.searchsorted(pend, jnp.arange(n_blocks) * MOE_BLOCK, side='right'), N_EXPERTS - 1)

    def step(acc, inp):
        tok, wb, e = inp
        xb = xt[tok]
        hb = jax.nn.silu(xb @ w_gate[e]) * (xb @ w_up[e])
        yb = (hb @ w_down[e]).astype(F32) * wb[:, None]
        return acc.at[tok].add(yb), None

    routed, _ = lax.scan(step, jnp.zeros((T, D), F32),
                         (buf_tok.reshape(n_blocks, MOE_BLOCK), buf_w.reshape(n_blocks, MOE_BLOCK), block_e))
    shared = (jax.nn.silu(xt @ s_gate) * (xt @ s_up)) @ s_down
    return (routed + shared.astype(F32)).astype(h.dtype).reshape(Bsz, L, D)


def setup_inputs(seed: int = 0) -> dict:
    key = jax.random.key(seed)
    ks = jax.random.split(key, 32)
    nrm = lambda k, shape, scale: jax.random.normal(k, shape, F32) * scale
    D, E, FF = D_MODEL, N_EXPERTS, D_EXPERT
    lam_im = (jnp.pi * jnp.arange(S5_STATE, dtype=F32))[None, None, :] + nrm(ks[4], (N_EVEN, S5_GROUPS, S5_STATE), 0.01)
    return {
        'x': nrm(ks[0], (BATCH, SEQ, D), 1.0),
        'meta': nrm(ks[1], (N_META, D), 1.0),
        'ab_w_in': nrm(ks[2], (N_EVEN, D, AB_COLS), D ** -0.5),
        's5_log_dt': jax.random.uniform(ks[3], (N_EVEN, S5_GROUPS), F32, math.log(0.001), math.log(0.1)),
        's5_lambda_re': -0.5 + nrm(ks[5], (N_EVEN, S5_GROUPS, S5_STATE), 0.01),
        's5_lambda_im': lam_im,
        's5_b_re': nrm(ks[6], (N_EVEN, S5_GROUPS, S5_STATE, S5_GROUP), (2 * S5_GROUP) ** -0.5),
        's5_b_im': nrm(ks[7], (N_EVEN, S5_GROUPS, S5_STATE, S5_GROUP), (2 * S5_GROUP) ** -0.5),
        's5_c_re': nrm(ks[8], (N_EVEN, S5_GROUPS, S5_GROUP, S5_STATE), S5_STATE ** -0.5),
        's5_c_im': nrm(ks[9], (N_EVEN, S5_GROUPS, S5_GROUP, S5_STATE), S5_STATE ** -0.5),
        's5_d': nrm(ks[10], (N_EVEN, S5_WIDTH), 1.0),
        's5_w_glu': nrm(ks[11], (N_EVEN, S5_WIDTH, S5_WIDTH), S5_WIDTH ** -0.5),
        'gla_w_gate2': nrm(ks[12], (N_EVEN, GLA_RANK, GLA_QK), GLA_RANK ** -0.5),
        'gla_b_gate': nrm(ks[13], (N_EVEN, GLA_QK), 0.1),
        'gla_norm_g': 1.0 + nrm(ks[14], (N_EVEN, GLA_WIDTH), 0.02),
        'ab_w_out': nrm(ks[15], (N_EVEN, S5_WIDTH + GLA_WIDTH, D), (S5_WIDTH + GLA_WIDTH) ** -0.5 * DEEPNORM_BETA),
        'ret_w_in': nrm(ks[16], (N_ODD, D, RET_COLS), D ** -0.5),
        'ret_norm_g': 1.0 + nrm(ks[17], (N_ODD, RET_WIDTH), 0.02),
        'ret_w_out': nrm(ks[18], (N_ODD, RET_WIDTH, D), RET_WIDTH ** -0.5 * DEEPNORM_BETA),
        'ln1_g': 1.0 + nrm(ks[19], (DEPTH, D), 0.02),
        'ln1_b': nrm(ks[20], (DEPTH, D), 0.02),
        'ln2_g': 1.0 + nrm(ks[21], (DEPTH, D), 0.02),
        'ln2_b': nrm(ks[22], (DEPTH, D), 0.02),
        'moe_router': nrm(ks[23], (DEPTH, D, E), D ** -0.5),
        'moe_bias': nrm(ks[24], (DEPTH, E), 0.01),
        'moe_w_gate': nrm(ks[25], (DEPTH, E, D, FF), D ** -0.5),
        'moe_w_up': nrm(ks[26], (DEPTH, E, D, FF), D ** -0.5),
        'moe_w_down': nrm(ks[27], (DEPTH, E, FF, D), FF ** -0.5 * DEEPNORM_BETA),
        'shared_w_gate': nrm(ks[28], (DEPTH, D, FF), D ** -0.5),
        'shared_w_up': nrm(ks[29], (DEPTH, D, FF), D ** -0.5),
        'shared_w_down': nrm(ks[30], (DEPTH, FF, D), FF ** -0.5 * DEEPNORM_BETA),
    }


def reference(x, meta, ab_w_in, s5_log_dt, s5_lambda_re, s5_lambda_im, s5_b_re, s5_b_im, s5_c_re, s5_c_im,
              s5_d, s5_w_glu, gla_w_gate2, gla_b_gate, gla_norm_g, ab_w_out, ret_w_in, ret_norm_g, ret_w_out,
              ln1_g, ln1_b, ln2_g, ln2_b, moe_router, moe_bias, moe_w_gate, moe_w_up, moe_w_down,
              shared_w_gate, shared_w_up, shared_w_down):
    Bsz = x.shape[0]
    h = jnp.concatenate([jnp.broadcast_to(meta[None].astype(x.dtype), (Bsz, N_META, D_MODEL)), x], axis=1)
    for layer in range(DEPTH):
        i = layer // 2
        if layer % 2 == 0:
            mix = ab_mixer(h, ab_w_in[i], s5_log_dt[i], s5_lambda_re[i], s5_lambda_im[i], s5_b_re[i], s5_b_im[i],
                           s5_c_re[i], s5_c_im[i], s5_d[i], s5_w_glu[i], gla_w_gate2[i], gla_b_gate[i],
                           gla_norm_g[i], ab_w_out[i])
        else:
            mix = retention_mixer(h, ret_w_in[i], ret_norm_g[i], ret_w_out[i])
        h = layer_norm(DEEPNORM_ALPHA * h + mix.astype(h.dtype), ln1_g[layer], ln1_b[layer])
        ffn = moe(h, moe_router[layer], moe_bias[layer], moe_w_gate[layer], moe_w_up[layer], moe_w_down[layer],
                  shared_w_gate[layer], shared_w_up[layer], shared_w_down[layer])
        h = layer_norm(DEEPNORM_ALPHA * h + ffn, ln2_g[layer], ln2_b[layer])
    return h[:, N_META:]
```

```cpp
#include <hip/hip_runtime.h>
#include <cstdio>
#include <cstdint>

#define DI __device__ __forceinline__
#define LAS __attribute__((address_space(3)))
#define GAS __attribute__((address_space(1)))
typedef unsigned short bf16;
typedef short bf16x8 __attribute__((ext_vector_type(8)));
typedef short s16x4 __attribute__((ext_vector_type(4)));
typedef float f32x4 __attribute__((ext_vector_type(4)));
typedef float f32x2 __attribute__((ext_vector_type(2)));
typedef unsigned u32x4 __attribute__((ext_vector_type(4)));
typedef unsigned u32x2 __attribute__((ext_vector_type(2)));
typedef __bf16 bf2_t __attribute__((ext_vector_type(2)));
typedef GAS unsigned gu32;
#define RLX_AGENT __ATOMIC_RELAXED, __HIP_MEMORY_SCOPE_AGENT
#define MFMA16(a, b, c) __builtin_amdgcn_mfma_f32_16x16x32_bf16((a), (b), (c), 0, 0, 0)

DI unsigned pk2(float lo, float hi) { bf2_t v; v.x = (__bf16)lo; v.y = (__bf16)hi; return __builtin_bit_cast(unsigned, v); }
DI bf16 f2bf(float f) { return (bf16)(pk2(f, 0.f) & 0xffffu); }
DI float bf2f(unsigned b) { return __uint_as_float(b << 16); }
DI float bflo(unsigned w) { return __uint_as_float(w << 16); }
DI float bfhi(unsigned w) { return __uint_as_float(w & 0xffff0000u); }
DI u32x4 pk8(f32x4 a, f32x4 b) { u32x4 w; w.x = pk2(a[0], a[1]); w.y = pk2(a[2], a[3]); w.z = pk2(b[0], b[1]); w.w = pk2(b[2], b[3]); return w; }
DI float sigmoidf_(float x) { return 1.0f / (1.0f + __expf(-x)); }
DI float siluf_(float x) { return x / (1.0f + __expf(-x)); }
DI float gelu_tanh(float x) { const float u = 0.7978845608028654f * (x + 0.044715f * x * x * x); const float e = __expf(-2.0f * fabsf(u)); const float t = (1.0f - e) / (1.0f + e); return 0.5f * x * (1.0f + (u < 0.f ? -t : t)); }
DI float wave_sum(float v) {
#pragma unroll
    for (int o = 1; o < 64; o <<= 1) v += __shfl_xor(v, o);
    return v;
}

constexpr int D = 2048, NB = 4, SEQ = 2048, TM = 8192, NMETA = 16, TR = TM + NMETA, TRP = 8448;
constexpr int S5W = 1024, GQK = 512, GWD = 1024, ABC = 4112, GDK = 128, GDV = 256;
constexpr int RQK = 2048, RWD = 4096, RETC = 12288, RDK = 256, RDV = 512, RH = 8;
constexpr int NE = 64, NEX = 65, FF = 512, TOPK = 8;
constexpr float ALPHA = 1.4142135623730951f;
constexpr float LN_EPS = 1e-5f;
constexpr int NWAVES = 8, NTHR = 512;

constexpr size_t MiB = 1u << 20;
constexpr size_t WS_CTL = 0, CTL_ZERO_BYTES = 4 * MiB;
constexpr size_t WS_WIN0T = 4 * MiB;
constexpr size_t WS_WGLUT = 21 * MiB;
constexpr size_t WS_WOUT0T = 23 * MiB;
constexpr size_t WS_WIN1T = 31 * MiB;
constexpr size_t WS_WOUT1T = 79 * MiB;
constexpr size_t WS_RT = 95 * MiB;
constexpr size_t WS_TM = 96 * MiB;
constexpr size_t WS_BKT = 108 * MiB;
constexpr size_t WS_A16 = 112 * MiB;
constexpr size_t WS_ROPE = 113 * MiB;
constexpr size_t WS_WGU = 116 * MiB;
constexpr size_t WS_WD = 636 * MiB;
constexpr size_t WS_XB = 896 * MiB;
constexpr size_t WS_U = 929 * MiB;
constexpr size_t WS_UMETA = 945 * MiB;
constexpr size_t WS_QRAW = 946 * MiB;
constexpr size_t WS_KRAW = 955 * MiB;
constexpr size_t WS_R = 964 * MiB;
constexpr size_t WS_VT0 = 981 * MiB;
constexpr size_t WS_Z = 997 * MiB;
constexpr size_t WS_MIXED0 = 1014 * MiB;
constexpr size_t WS_QS = 1047 * MiB;
constexpr size_t WS_KN = 1056 * MiB;
constexpr size_t WS_ST0 = 1065 * MiB;
constexpr size_t WS_GL = 1097 * MiB;
constexpr size_t WS_PMETA = 1098 * MiB;
constexpr size_t WS_DC0 = 1099 * MiB;
constexpr size_t WS_SMETA0 = 1100 * MiB;
constexpr size_t WS_KVMETA = 1101 * MiB;
constexpr size_t WS_ROUTE = 1102 * MiB;
constexpr size_t WS_ROWIDX = 1103 * MiB;
constexpr size_t WS_Y0 = 1106 * MiB;
constexpr size_t WS_H1F = 1172 * MiB;
constexpr size_t WS_H1B = 1238 * MiB;
constexpr size_t WS_H2F = 1271 * MiB;
constexpr size_t WS_H2B = 1337 * MiB;
constexpr size_t WS_HBUF = 1370 * MiB;
constexpr size_t WS_YBUF = 1459 * MiB;
constexpr size_t WS_END = 1812 * MiB;
constexpr size_t WS_PQ = WS_YBUF;
constexpr size_t WS_KN1 = WS_YBUF + 64 * MiB;
constexpr size_t WS_KNT1 = WS_YBUF + 97 * MiB;
constexpr size_t WS_VS = WS_YBUF + 129 * MiB;
constexpr size_t WS_GATE1 = WS_YBUF + 257 * MiB;
constexpr size_t WS_O1 = WS_XB;
constexpr size_t WS_MIXED1 = WS_VT0;
static_assert(WS_O1 + 64 * MiB <= WS_VT0 && WS_MIXED1 + 64 * MiB <= WS_QS, "layer-1 aliases");
static_assert(WS_GATE1 + 66 * MiB <= WS_END, "gate1");
constexpr int MAXSLOTS = 90368;
constexpr int CW_BAR = 4096;
constexpr int CW_CNT = 65536;
constexpr int XCD_BAR_WORDS_C = 3456;
constexpr int MAX_LAUNCH = 16;
static_assert(CW_BAR + MAX_LAUNCH * XCD_BAR_WORDS_C <= CW_CNT, "ctl map");

constexpr int RING_BYTES = 131072;
constexpr int MISC_OFF = RING_BYTES;
constexpr int LDS_BYTES = 147456;

#define XB_TMO      128
#define XB_XCNT(j)  (256  + 64 * (j))
#define XB_XSUB(j)  (1280 + 64 * (j))
#define XB_XGEN(j)  (2304 + 64 * (j))
#define XB_TOP      3328
#define XB_TOPGEN   3392
#define XCD_BAR_WORDS 3456
#define XB_SPIN_CAP (1u << 18)
DI unsigned xb_ld(unsigned* p)              { return __hip_atomic_load(p, __ATOMIC_RELAXED, __HIP_MEMORY_SCOPE_AGENT); }
DI unsigned xb_add(unsigned* p, unsigned v) { return __hip_atomic_fetch_add(p, v, __ATOMIC_RELAXED, __HIP_MEMORY_SCOPE_AGENT); }
DI unsigned xb_xcc_id() { return (unsigned)__builtin_amdgcn_s_getreg((3 << 11) | 20) & 0xFu; }
#define XB_SPIN(cond, bar) do { unsigned _sp = 0; while (cond) { __builtin_amdgcn_s_sleep(1); \
    if ((++_sp & 255u) == 0u) { if (xb_ld(&(bar)[XB_TMO])) break; if (_sp > XB_SPIN_CAP) { atomicAdd(&(bar)[XB_TMO], 1u); break; } } } } while (0)
struct XcdBarrier { unsigned* bar; unsigned x; volatile LAS unsigned* st; };
DI XcdBarrier xcd_barrier_post(unsigned* bar, volatile LAS unsigned* st) {
    XcdBarrier b; b.bar = bar; b.x = xb_xcc_id(); b.st = st;
    if (threadIdx.x == 0) (void)xb_add(&bar[XB_XCNT(b.x)], 1u);
    return b;
}
DI void xcd_barrier_complete(unsigned* bar, unsigned x, unsigned& nloc, unsigned& nx) {
    const unsigned G = gridDim.x * gridDim.y * gridDim.z;
    unsigned sum, cnt, mine, sp = 0u;
    for (;;) {
        sum = 0u; cnt = 0u; mine = 0u;
#pragma unroll
        for (unsigned j = 0; j < 16; ++j) { const unsigned c = xb_ld(&bar[XB_XCNT(j)]); sum += c; cnt += (c > 0u) ? 1u : 0u; mine = (j == x) ? c : mine; }
        if (sum == G) break;
        __builtin_amdgcn_s_sleep(1);
        if ((++sp & 255u) == 0u) { if (xb_ld(&bar[XB_TMO])) break; if (sp > XB_SPIN_CAP) { atomicAdd(&bar[XB_TMO], 1u); break; } }
    }
    nloc = mine > 0u ? mine : 1u; nx = cnt > 0u ? cnt : 1u;
}
DI void xcd_barrier(const XcdBarrier& b) {
    asm volatile("s_waitcnt vmcnt(0)" ::: "memory");
    __syncthreads();
    if (threadIdx.x == 0) {
        unsigned* bar = b.bar;
        __builtin_amdgcn_s_waitcnt(0);
        unsigned nloc = b.st[0], nx = b.st[1];
        if (nloc == 0u) { xcd_barrier_complete(bar, b.x, nloc, nx); b.st[0] = nloc; b.st[1] = nx; }
        const unsigned old = xb_add(&bar[XB_XSUB(b.x)], 1u);
        const unsigned gen = old / nloc;
        if (old + 1u == (gen + 1u) * nloc) {
            __builtin_amdgcn_fence(__ATOMIC_RELEASE, "agent");
            asm volatile("s_waitcnt vmcnt(0)" ::: "memory");
            const unsigned og = xb_add(&bar[XB_TOP], 1u);
            const unsigned tg = og / nx;
            if (og + 1u == (tg + 1u) * nx) xb_add(&bar[XB_TOPGEN], 1u);
            else XB_SPIN(xb_ld(&bar[XB_TOPGEN]) == tg, bar);
            __builtin_amdgcn_fence(__ATOMIC_ACQUIRE, "agent");
            xb_add(&bar[XB_XGEN(b.x)], 1u);
            asm volatile("s_waitcnt vmcnt(0)" ::: "memory");
        } else {
            XB_SPIN(xb_ld(&bar[XB_XGEN(b.x)]) == gen, bar);
            __builtin_amdgcn_fence(__ATOMIC_ACQUIRE, "agent");
            asm volatile("s_waitcnt vmcnt(0)" ::: "memory");
        }
    }
    __syncthreads();
}
namespace pg8 {
constexpr int BM = 256, BK = 64, HALF = 128, HTB = HALF * BK * 2, STAGE_BYTES = 8 * HTB;
DI int lds_byte(int r, int c) { const int st = (r >> 4) * 2 + (c >> 5), rr = r & 15, cc = c & 31, ob = rr * 64 + cc * 2; return st * 1024 + (ob ^ (((ob >> 9) & 1) << 5)); }
DI void stage_rc(int b, int& R, int& C) { const int st = b / 1024, sb = b % 1024, swz = sb ^ (((sb >> 9) & 1) << 5); R = (st >> 1) * 16 + swz / 64; C = (st & 1) * 32 + (swz % 64) / 2; }
DI int perm32(int rho) { const int n = rho >> 4, i = rho & 15; return 8 * (i >> 2) + 4 * n + (i & 3); }
DI int permrow(int R) { return (R & ~31) + perm32(R & 31); }

struct GUnit { const char* A; const char* B; const int* rows; int r0, c0, aux, nvalid; };

template <class Epi, class Sched, bool TRANS>
DI void gemm_phase(LAS unsigned char* lds, const Sched& S, const Epi& E) {
    const int tid = threadIdx.x, wid = __builtin_amdgcn_readfirstlane(tid >> 6), lane = tid & 63, wr = wid >> 2, wc = wid & 3, fr = lane & 15, fq = lane >> 4;
    const int K = S.K, nt = K / BK;
    const unsigned lda = (unsigned)S.lda, ldb = (unsigned)S.ldb;
    int Rl[2], Cl[2];
#pragma unroll
    for (int i = 0; i < 2; ++i) stage_rc(tid * 16 + i * 8192, Rl[i], Cl[i]);
    unsigned voffB[2][2], voffA[2][2], nvoffA[2][2];
#pragma unroll
    for (int h = 0; h < 2; ++h)
#pragma unroll
        for (int i = 0; i < 2; ++i) {
            const int Rb = h * HALF + (TRANS ? Rl[i] : permrow(Rl[i])), Ra = h * HALF + (TRANS ? permrow(Rl[i]) : Rl[i]);
            voffB[h][i] = (unsigned)Rb * ldb + (unsigned)Cl[i] * 2u; voffA[h][i] = (unsigned)Ra * lda + (unsigned)Cl[i] * 2u; nvoffA[h][i] = voffA[h][i];
        }
    const size_t kstep = (size_t)(BK * 2);
    const unsigned ldsw = (unsigned)wid * 1024u;
    const int aoff = lds_byte(wr * 64 + fr, fq * 8), boff = lds_byte(wc * 32 + fr, fq * 8);
#define PG8_SA(b, h) (((b) * 2 + (h)) * HTB)
#define PG8_SB(b, h) ((4 + (b) * 2 + (h)) * HTB)
#define PG8_STAGE(bufoff, gbase, voff) do { _Pragma("unroll") for (int _i = 0; _i < 2; ++_i) \
        __builtin_amdgcn_global_load_lds((const unsigned*)((const char*)(gbase) + (voff)[_i]), (LAS unsigned*)(lds + (bufoff) + ldsw + _i * 8192), 16, 0, 0); } while (0)
#define PG8_LDA(dst, b, h) do { _Pragma("unroll") for (int m = 0; m < 4; ++m) _Pragma("unroll") for (int k = 0; k < 2; ++k) dst[m][k] = *(const LAS bf16x8*)(lds + PG8_SA(b, h) + aoff + m * 2048 + k * 1024); } while (0)
#define PG8_LDB(dst, b, h) do { _Pragma("unroll") for (int n = 0; n < 2; ++n) _Pragma("unroll") for (int k = 0; k < 2; ++k) dst[n][k] = *(const LAS bf16x8*)(lds + PG8_SB(b, h) + boff + n * 2048 + k * 1024); } while (0)
#define PG8_MMA(ai, bj, At, Bt) do { __builtin_amdgcn_s_setprio(1); _Pragma("unroll") for (int m = 0; m < 4; ++m) _Pragma("unroll") for (int n = 0; n < 2; ++n) _Pragma("unroll") for (int k = 0; k < 2; ++k) \
        acc[ai][bj][m][n] = TRANS ? __builtin_amdgcn_mfma_f32_16x16x32_bf16(At[m][k], Bt[n][k], acc[ai][bj][m][n], 0, 0, 0) \
                                  : __builtin_amdgcn_mfma_f32_16x16x32_bf16(Bt[n][k], At[m][k], acc[ai][bj][m][n], 0, 0, 0); __builtin_amdgcn_s_setprio(0); } while (0)
#define PG8_WAIT_V(n) asm volatile("s_waitcnt vmcnt(" #n ")" ::: "memory")
#define PG8_WAIT_L(n) asm volatile("s_waitcnt lgkmcnt(" #n ")" ::: "memory")
#define PG8_BAR __builtin_amdgcn_s_barrier()
#define PG8_SCHED __builtin_amdgcn_sched_barrier(0)
#define PG8_GIDX(dst, u) do { _Pragma("unroll") for (int _h = 0; _h < 2; ++_h) _Pragma("unroll") for (int _i = 0; _i < 2; ++_i) { \
        const int _r = _h * HALF + Rl[_i]; dst[_h][_i] = (u).rows[_r < (u).nvalid ? _r : 0]; } } while (0)
#define PG8_GOFF(dst, src) do { _Pragma("unroll") for (int _h = 0; _h < 2; ++_h) _Pragma("unroll") for (int _i = 0; _i < 2; ++_i) dst[_h][_i] = (unsigned)src[_h][_i] * lda + (unsigned)Cl[_i] * 2u; } while (0)
    GUnit cur, nxt, nn2; int ui = 0; int nidx[2][2] = {{0, 0}, {0, 0}};
    if (!S.next(0, cur)) return;
    if constexpr (Sched::GATHER) { PG8_GIDX(nidx, cur); PG8_GOFF(voffA, nidx); if (S.next(1, nxt)) { PG8_GIDX(nidx, nxt); } }
    f32x4 acc[2][2][4][2];
#pragma unroll
    for (int a = 0; a < 2; ++a)
#pragma unroll
        for (int b = 0; b < 2; ++b)
#pragma unroll
            for (int m = 0; m < 4; ++m)
#pragma unroll
                for (int n = 0; n < 2; ++n) acc[a][b][m][n] = (f32x4){0.f, 0.f, 0.f, 0.f};
    bf16x8 At[4][2], B0[2][2], B1[2][2];
    const char* cA = cur.A; const char* cB = cur.B;
    PG8_STAGE(PG8_SB(0, 0), cB, voffB[0]); PG8_STAGE(PG8_SB(0, 1), cB, voffB[1]); PG8_STAGE(PG8_SA(0, 0), cA, voffA[0]); PG8_STAGE(PG8_SA(0, 1), cA, voffA[1]);
    if (wr == 1) PG8_BAR;
    PG8_WAIT_V(2); PG8_BAR;
    PG8_STAGE(PG8_SB(1, 0), cB + kstep, voffB[0]); PG8_STAGE(PG8_SA(1, 0), cA + kstep, voffA[0]); PG8_STAGE(PG8_SB(1, 1), cB + kstep, voffB[1]);
    PG8_WAIT_V(6); PG8_BAR;
    for (;;) {
        const bool has_next = S.next(ui + 1, nxt);
        if constexpr (Sched::GATHER) {
            if (has_next) { PG8_GOFF(nvoffA, nidx); } else {
#pragma unroll
            for (int h = 0; h < 2; ++h)
#pragma unroll
                for (int i = 0; i < 2; ++i) nvoffA[h][i] = voffA[h][i]; }
            if (has_next && S.next(ui + 2, nn2)) { PG8_GIDX(nidx, nn2); } }
        const char* nA = has_next ? nxt.A : cA; const char* nB = has_next ? nxt.B : cB;
        for (int t = 0; t < nt; t += 2) {
            const bool last = (t == nt - 2);
            const char* a1 = cA + (size_t)(t + 1) * kstep;
            const char* a2 = last ? nA : cA + (size_t)(t + 2) * kstep; const char* b2 = last ? nB : cB + (size_t)(t + 2) * kstep;
            const char* a3 = a2 + kstep; const char* b3 = b2 + kstep;
            unsigned va0[2], va1[2];
#pragma unroll
            for (int i = 0; i < 2; ++i) { va0[i] = (Sched::GATHER && last) ? nvoffA[0][i] : voffA[0][i]; va1[i] = (Sched::GATHER && last) ? nvoffA[1][i] : voffA[1][i]; }
            PG8_LDB(B0, 0, 0); PG8_LDB(B1, 0, 1); PG8_SCHED; PG8_LDA(At, 0, 0); PG8_STAGE(PG8_SA(1, 1), a1, voffA[1]);
            PG8_WAIT_V(8); PG8_WAIT_L(0); PG8_BAR; PG8_MMA(0, 0, At, B0); PG8_MMA(0, 1, At, B1); PG8_BAR; PG8_SCHED;
            PG8_LDA(At, 0, 1); PG8_STAGE(PG8_SB(0, 0), b2, voffB[0]); PG8_STAGE(PG8_SB(0, 1), b2, voffB[1]); PG8_STAGE(PG8_SA(0, 0), a2, va0);
            PG8_WAIT_V(8); PG8_WAIT_L(0); PG8_BAR; PG8_MMA(1, 0, At, B0); PG8_MMA(1, 1, At, B1); PG8_BAR; PG8_SCHED;
            PG8_LDB(B0, 1, 0); PG8_LDB(B1, 1, 1); PG8_SCHED; PG8_LDA(At, 1, 0); PG8_STAGE(PG8_SA(0, 1), a2, va1);
            PG8_WAIT_V(8); PG8_WAIT_L(0); PG8_BAR; PG8_MMA(0, 0, At, B0); PG8_MMA(0, 1, At, B1); PG8_BAR; PG8_SCHED;
            PG8_LDA(At, 1, 1); PG8_STAGE(PG8_SB(1, 0), b3, voffB[0]); PG8_STAGE(PG8_SB(1, 1), b3, voffB[1]); PG8_STAGE(PG8_SA(1, 0), a3, va0);
            PG8_WAIT_V(8); PG8_WAIT_L(0); PG8_BAR; PG8_MMA(1, 0, At, B0); PG8_MMA(1, 1, At, B1); PG8_BAR; PG8_SCHED;
        }
        if (wr == 0) PG8_BAR;
        E(acc, cur, wr, wc, fr, fq);
        if (!has_next) break;
#pragma unroll
        for (int a = 0; a < 2; ++a)
#pragma unroll
            for (int b = 0; b < 2; ++b)
#pragma unroll
                for (int m = 0; m < 4; ++m)
#pragma unroll
                    for (int n = 0; n < 2; ++n) acc[a][b][m][n] = (f32x4){0.f, 0.f, 0.f, 0.f};
        cur = nxt; cA = nA; cB = nB; ++ui;
        if constexpr (Sched::GATHER) {
#pragma unroll
            for (int h = 0; h < 2; ++h)
#pragma unroll
                for (int i = 0; i < 2; ++i) voffA[h][i] = nvoffA[h][i]; }
        if (wr == 1) PG8_BAR;
    }
    PG8_WAIT_V(0);
    PG8_BAR;
#undef PG8_SA
#undef PG8_SB
#undef PG8_STAGE
#undef PG8_LDA
#undef PG8_LDB
#undef PG8_MMA
#undef PG8_WAIT_V
#undef PG8_WAIT_L
#undef PG8_BAR
#undef PG8_SCHED
#undef PG8_GIDX
#undef PG8_GOFF
}
}
using pg8::GUnit;
struct DenseSched {
    static constexpr bool GATHER = false;
    int lda, ldb, K;
    const char* A; const char* B;
    int nM, nN, G, c, nN1, ct0, ct1;
    DI void init(const void* A_, int lda_, const void* B_, int ldb_, int K_, int nM_, int nN1_, int ct0_, int nN2_, int ct1_, int G_, int c_) {
        A = (const char*)A_; B = (const char*)B_; lda = lda_; ldb = ldb_; K = K_; nM = nM_; nN1 = nN1_; ct0 = ct0_; ct1 = ct1_; nN = nN1_ + nN2_; G = G_; c = c_; }
    DI bool next(int i, GUnit& u) const {
        const int nwg = nM * nN; const long L = (long)i * G + c; if (L >= nwg) return false;
        int wgid = (int)L; { const int q = nwg / 8, r = nwg % 8, xcd = wgid % 8, off = wgid / 8; wgid = (xcd < r ? xcd * (q + 1) : r * (q + 1) + (xcd - r) * q) + off; }
        const int nig = 8 * nN, gid = wgid / nig, fm = gid * 8, gsz = (nM - fm) < 8 ? (nM - fm) : 8;
        const int pm = fm + ((wgid % nig) % gsz), pn = (wgid % nig) / gsz;
        const int ct = pn < nN1 ? ct0 + pn : ct1 + (pn - nN1);
        u.A = A + (size_t)pm * 256 * (size_t)lda; u.B = B + (size_t)ct * 256 * (size_t)ldb; u.rows = nullptr; u.r0 = pm * 256; u.c0 = ct * 256; u.aux = 0; u.nvalid = 256; return true;
    }
};
struct BatchSched {
    static constexpr bool GATHER = false;
    int lda, ldb, K;
    const char* A; const char* B;
    size_t sA_g, sA_j, sB_b, sB_h, sB_sc, sB_g, sB_j;
    int per, n, G, c;
    DI bool next(int i, GUnit& u) const {
        const long L = (long)i * G + c; if (L >= n) return false;
        const int g = (int)L / per, j = (int)L % per, b = g >> 6, h = (g >> 3) & 7, sc = g & 7;
        u.A = A + g * sA_g + j * sA_j; u.B = B + b * sB_b + h * sB_h + sc * sB_sc + g * sB_g + j * sB_j; u.rows = nullptr; u.r0 = j * 256; u.c0 = 0; u.aux = g; u.nvalid = 256; return true;
    }
};
struct MoeSched {
    static constexpr bool GATHER_ = true;
    int lda, ldb, K;
    const volatile LAS int* TP; const volatile LAS int* CNT;
    const char* A; const char* B; const int* rowidx;
    int nct, ntiles, G, c, down;
    size_t bstride;
    DI bool next_(int i, GUnit& u) const {
        const long L = (long)i * G + c; if (L >= (long)ntiles * nct) return false;
        const int rt = (int)L / nct, ct = (int)L % nct;
        int e = 0;
        for (int k = 1; k < NEX; ++k) e = (TP[k] <= rt) ? k : e;
        const int j = rt - TP[e];
        u.r0 = rt * 256; u.aux = ct; u.c0 = ct * 256;
        if (down) { u.A = A + (size_t)rt * 256 * (size_t)lda; u.rows = nullptr; u.nvalid = 256; }
        else { u.A = A; u.rows = rowidx + (size_t)e * TRP + j * 256; const int rem = CNT[e] - j * 256; u.nvalid = rem < 256 ? rem : 256; }
        u.B = B + (size_t)e * bstride + (size_t)ct * 256 * (size_t)ldb;
        return true;
    }
};
struct MoeSchedGU : MoeSched { static constexpr bool GATHER = true;  DI bool next(int i, GUnit& u) const { return next_(i, u); } };
struct MoeSchedDN : MoeSched { static constexpr bool GATHER = false; DI bool next(int i, GUnit& u) const { return next_(i, u); } };

#define EPI_ARGS const f32x4 (&acc)[2][2][4][2], const GUnit& u, int wr, int wc, int fr, int fq
struct EpiIn0 {
    bf16 *U, *Q, *Kr, *R;
    DI void operator()(EPI_ARGS) const {
        const int c0 = u.c0;
#pragma unroll
        for (int ai = 0; ai < 2; ++ai)
#pragma unroll
            for (int m = 0; m < 4; ++m) {
                const int r = u.r0 + ai * 128 + wr * 64 + m * 16 + fr;
#pragma unroll
                for (int bj = 0; bj < 2; ++bj) {
                    const int c = c0 + bj * 128 + wc * 32 + fq * 8;
                    f32x4 v0 = acc[ai][bj][m][0], v1 = acc[ai][bj][m][1];
                    if (c0 < 1024) { const int b = r >> 11, s = r & 2047, g = c >> 4, ch = c & 15;
                        *(u32x4*)(U + (((size_t)(b * 64 + g) * 2048 + s) * 16 + ch)) = pk8(v0, v1); }
                    else if (c0 < 1536) { const float sc = 0.08838834764831845f; *(u32x4*)(Q + (size_t)r * 512 + (c - 1024)) = pk8(v0 * sc, v1 * sc); }
                    else if (c0 < 2048) { *(u32x4*)(Kr + (size_t)r * 512 + (c - 1536)) = pk8(v0, v1); }
                    else { f32x4 a, b2;
#pragma unroll
                        for (int i = 0; i < 4; ++i) { a[i] = siluf_(v0[i]); b2[i] = siluf_(v1[i]); }
                        *(u32x4*)(R + (size_t)r * 1024 + (c - 3072)) = pk8(a, b2); }
                }
            }
    }
};
struct EpiVT0 {
    bf16* VT;
    DI void operator()(EPI_ARGS) const {
#pragma unroll
        for (int ai = 0; ai < 2; ++ai)
#pragma unroll
            for (int mp = 0; mp < 2; ++mp) {
                const int r = u.r0 + ai * 128 + wr * 64 + mp * 32 + fq * 8, b = r >> 11, s = r & 2047;
#pragma unroll
                for (int bj = 0; bj < 2; ++bj)
#pragma unroll
                    for (int n = 0; n < 2; ++n) {
                        const int c = u.c0 - 2048 + bj * 128 + wc * 32 + n * 16 + fr;
                        *(u32x4*)(VT + ((size_t)(b * 1024 + c) * 2048 + s)) = pk8(acc[ai][bj][2 * mp][n], acc[ai][bj][2 * mp + 1][n]);
                    }
            }
    }
};
struct EpiGlu {
    const bf16* Z; bf16* MX;
    DI void operator()(EPI_ARGS) const {
#pragma unroll
        for (int ai = 0; ai < 2; ++ai)
#pragma unroll
            for (int m = 0; m < 4; ++m) {
                const int r = u.r0 + ai * 128 + wr * 64 + m * 16 + fr;
#pragma unroll
                for (int bj = 0; bj < 2; ++bj) {
                    const int c = u.c0 + bj * 128 + wc * 32 + fq * 8;
                    const u32x4 z = *(const u32x4*)(Z + (size_t)r * 1024 + c);
                    f32x4 v0 = acc[ai][bj][m][0], v1 = acc[ai][bj][m][1], o0, o1;
                    o0[0] = bflo(z.x) * sigmoidf_(v0[0]); o0[1] = bfhi(z.x) * sigmoidf_(v0[1]); o0[2] = bflo(z.y) * sigmoidf_(v0[2]); o0[3] = bfhi(z.y) * sigmoidf_(v0[3]);
                    o1[0] = bflo(z.z) * sigmoidf_(v1[0]); o1[1] = bfhi(z.z) * sigmoidf_(v1[1]); o1[2] = bflo(z.w) * sigmoidf_(v1[2]); o1[3] = bfhi(z.w) * sigmoidf_(v1[3]);
                    *(u32x4*)(MX + (size_t)r * 2048 + c) = pk8(o0, o1);
                }
            }
    }
};
struct EpiOut {
    const float* resid; float* Y;
    DI void operator()(EPI_ARGS) const {
#pragma unroll
        for (int ai = 0; ai < 2; ++ai)
#pragma unroll
            for (int m = 0; m < 4; ++m) {
                const int r = u.r0 + ai * 128 + wr * 64 + m * 16 + fr;
#pragma unroll
                for (int bj = 0; bj < 2; ++bj) {
                    const size_t o = (size_t)r * 2048 + u.c0 + bj * 128 + wc * 32 + fq * 8;
                    const f32x4 x0 = *(const f32x4*)(resid + o), x1 = *(const f32x4*)(resid + o + 4);
                    *(f32x4*)(Y + o) = acc[ai][bj][m][0] + ALPHA * x0; *(f32x4*)(Y + o + 4) = acc[ai][bj][m][1] + ALPHA * x1;
                }
            }
    }
};
struct EpiMoeGU {
    bf16* H;
    DI void operator()(EPI_ARGS) const {
#pragma unroll
        for (int ai = 0; ai < 2; ++ai)
#pragma unroll
            for (int m = 0; m < 4; ++m) {
                const int r = u.r0 + ai * 128 + wr * 64 + m * 16 + fr;
                f32x4 o0, o1;
#pragma unroll
                for (int i = 0; i < 4; ++i) { o0[i] = siluf_(acc[ai][0][m][0][i]) * acc[ai][1][m][0][i]; o1[i] = siluf_(acc[ai][0][m][1][i]) * acc[ai][1][m][1][i]; }
                *(u32x4*)(H + (size_t)r * 512 + u.aux * 128 + wc * 32 + fq * 8) = pk8(o0, o1);
            }
    }
};
struct EpiMoeDN {
    bf16* Y;
    DI void operator()(EPI_ARGS) const {
#pragma unroll
        for (int ai = 0; ai < 2; ++ai)
#pragma unroll
            for (int m = 0; m < 4; ++m) {
                const int r = u.r0 + ai * 128 + wr * 64 + m * 16 + fr;
#pragma unroll
                for (int bj = 0; bj < 2; ++bj)
                    *(u32x4*)(Y + (size_t)r * 2048 + u.c0 + bj * 128 + wc * 32 + fq * 8) = pk8(acc[ai][bj][m][0], acc[ai][bj][m][1]);
            }
    }
};
DI float lg2gamma(int h) { return __log2f(1.0f - exp2f((float)(-5 - h))); }
struct EpiIn1 {
    bf16 *PQ, *KN, *GT; const f32x2* rope;
    DI void operator()(EPI_ARGS) const {
        const int c0 = u.c0;
        if (c0 >= 8192) {
#pragma unroll
            for (int ai = 0; ai < 2; ++ai)
#pragma unroll
                for (int m = 0; m < 4; ++m) {
                    const int r = u.r0 + ai * 128 + wr * 64 + m * 16 + fr;
#pragma unroll
                    for (int bj = 0; bj < 2; ++bj) { f32x4 a, b2;
#pragma unroll
                        for (int i = 0; i < 4; ++i) { a[i] = siluf_(acc[ai][bj][m][0][i]); b2[i] = siluf_(acc[ai][bj][m][1][i]); }
                        *(u32x4*)(GT + (size_t)r * 4096 + (c0 - 8192) + bj * 128 + wc * 32 + fq * 8) = pk8(a, b2); }
                }
            return;
        }
        const bool isq = c0 < 2048; const int h = (isq ? c0 : c0 - 2048) >> 8; const float l2g = lg2gamma(h);
#pragma unroll
        for (int ai = 0; ai < 2; ++ai)
#pragma unroll
            for (int m = 0; m < 4; ++m) {
                const int r = u.r0 + ai * 128 + wr * 64 + m * 16 + fr, b = r >> 11, s = r & 2047, il = s & 255, sc = s >> 8;
                const int j0 = wc * 32 + fq * 8;
                const f32x4* rp = (const f32x4*)(rope + (size_t)(16 + s) * 128 + j0);
                const float dec = isq ? exp2f((float)(il + 1) * l2g) : 0.0625f * exp2f(-(float)(il + 1) * l2g);
                f32x4 o1a, o1b, o2a, o2b;
#pragma unroll
                for (int n = 0; n < 2; ++n) {
                    const f32x4 cs0 = rp[2 * n], cs1 = rp[2 * n + 1];
                    const f32x4 t1 = acc[ai][0][m][n], t2 = acc[ai][1][m][n]; f32x4 p, q2;
                    p[0] = t1[0] * cs0[0] - t2[0] * cs0[1]; q2[0] = t1[0] * cs0[1] + t2[0] * cs0[0];
                    p[1] = t1[1] * cs0[2] - t2[1] * cs0[3]; q2[1] = t1[1] * cs0[3] + t2[1] * cs0[2];
                    p[2] = t1[2] * cs1[0] - t2[2] * cs1[1]; q2[2] = t1[2] * cs1[1] + t2[2] * cs1[0];
                    p[3] = t1[3] * cs1[2] - t2[3] * cs1[3]; q2[3] = t1[3] * cs1[3] + t2[3] * cs1[2];
                    if (n == 0) { o1a = p * dec; o2a = q2 * dec; } else { o1b = p * dec; o2b = q2 * dec; }
                }
                if (isq) { bf16* d = PQ + ((size_t)((b * 8 + h) * 8 + sc) * 256 + il) * 512 + 256 + j0; *(u32x4*)d = pk8(o1a, o1b); *(u32x4*)(d + 128) = pk8(o2a, o2b); }
                else { bf16* d = KN + (size_t)r * 2048 + h * 256 + j0; *(u32x4*)d = pk8(o1a, o1b); *(u32x4*)(d + 128) = pk8(o2a, o2b); }
            }
    }
};
struct EpiIn1T {
    bf16 *KNT, *VS; const f32x2* rope;
    DI void operator()(EPI_ARGS) const {
        const int c0 = u.c0;
        if (c0 >= 4096) {
#pragma unroll
            for (int ai = 0; ai < 2; ++ai)
#pragma unroll
                for (int mp = 0; mp < 2; ++mp) {
                    const int r = u.r0 + ai * 128 + wr * 64 + mp * 32 + fq * 8, b = r >> 11, s = r & 2047, il = s & 255, sc = s >> 8;
#pragma unroll
                    for (int bj = 0; bj < 2; ++bj)
#pragma unroll
                        for (int n = 0; n < 2; ++n) {
                            const int f = c0 - 4096 + bj * 128 + wc * 32 + n * 16 + fr, h = f >> 9, dv = f & 511;
                            *(u32x4*)(VS + ((size_t)((b * 8 + h) * 8 + sc) * 512 + dv) * 512 + il) = pk8(acc[ai][bj][2 * mp][n], acc[ai][bj][2 * mp + 1][n]);
                        }
                }
            return;
        }
        const int h = (c0 - 2048) >> 8; const float l2g = lg2gamma(h);
#pragma unroll
        for (int ai = 0; ai < 2; ++ai)
#pragma unroll
            for (int mp = 0; mp < 2; ++mp) {
                const int r = u.r0 + ai * 128 + wr * 64 + mp * 32 + fq * 8, b = r >> 11, s = r & 2047, il = s & 255;
#pragma unroll
                for (int n = 0; n < 2; ++n) {
                    const int j = wc * 32 + n * 16 + fr;
                    f32x4 o1a, o1b, o2a, o2b;
#pragma unroll
                    for (int t = 0; t < 8; ++t) {
                        const f32x2 cs = rope[(size_t)(16 + s + t) * 128 + j];
                        const float dec = 0.0625f * exp2f(-(float)(il + t + 1) * l2g);
                        const float t1 = acc[ai][0][2 * mp + (t >> 2)][n][t & 3], t2 = acc[ai][1][2 * mp + (t >> 2)][n][t & 3];
                        const float p = (t1 * cs.x - t2 * cs.y) * dec, q2 = (t1 * cs.y + t2 * cs.x) * dec;
                        if (t < 4) { o1a[t & 3] = p; o2a[t & 3] = q2; } else { o1b[t & 3] = p; o2b[t & 3] = q2; }
                    }
                    bf16* d = KNT + ((size_t)(b * 2048 + h * 256 + j) * 2048 + s);
                    *(u32x4*)d = pk8(o1a, o1b); *(u32x4*)(d + (size_t)128 * 2048) = pk8(o2a, o2b);
                }
            }
    }
};
struct EpiRetA {
    bf16* VS;
    DI void operator()(EPI_ARGS) const {
#pragma unroll
        for (int ai = 0; ai < 2; ++ai)
#pragma unroll
            for (int m = 0; m < 4; ++m) {
                const int r = u.r0 + ai * 128 + wr * 64 + m * 16 + fr;
#pragma unroll
                for (int bj = 0; bj < 2; ++bj)
                    *(u32x4*)(VS + ((size_t)u.aux * 512 + r) * 512 + 256 + bj * 128 + wc * 32 + fq * 8) = pk8(acc[ai][bj][m][0], acc[ai][bj][m][1]);
            }
    }
};
struct EpiRetP {
    bf16* PQ;
    DI void operator()(EPI_ARGS) const {
        asm volatile("" : "+v"(fr));
#pragma unroll
        for (int ai = 0; ai < 2; ++ai)
#pragma unroll
            for (int m = 0; m < 4; ++m) {
                const int r = ai * 128 + wr * 64 + m * 16 + fr;
#pragma unroll
                for (int bj = 0; bj < 2; ++bj) {
                    const int c = bj * 128 + wc * 32 + fq * 8; f32x4 a = acc[ai][bj][m][0], b2 = acc[ai][bj][m][1];
#pragma unroll
                    for (int i = 0; i < 4; ++i) {
                        a[i] = __uint_as_float(__float_as_uint(a[i]) & ~(unsigned)((r - c - i) >> 31)); b2[i] = __uint_as_float(__float_as_uint(b2[i]) & ~(unsigned)((r - c - 4 - i) >> 31)); }
                    *(u32x4*)(PQ + ((size_t)u.aux * 256 + r) * 512 + c) = pk8(a, b2);
                }
            }
    }
};
struct EpiRetO {
    bf16* O;
    DI void operator()(EPI_ARGS) const {
        const int g = u.aux, bh = g >> 3, sc = g & 7, b = bh >> 3, h = bh & 7;
#pragma unroll
        for (int ai = 0; ai < 2; ++ai)
#pragma unroll
            for (int m = 0; m < 4; ++m) {
                const int r = b * 2048 + sc * 256 + ai * 128 + wr * 64 + m * 16 + fr;
#pragma unroll
                for (int bj = 0; bj < 2; ++bj)
                    *(u32x4*)(O + (size_t)r * 4096 + h * 512 + u.r0 + bj * 128 + wc * 32 + fq * 8) = pk8(acc[ai][bj][m][0], acc[ai][bj][m][1]);
            }
    }
};
struct Frame {
    LAS unsigned char* lds;
    int tid, lane, wave, G, bid;
    unsigned char* ws;
    float* out;
    DI const float* inp(int i) const { const volatile LAS unsigned* t = (const volatile LAS unsigned*)(lds + 131072 + 2048);
        const unsigned lo = __builtin_amdgcn_readfirstlane(t[2 * i]), hi = __builtin_amdgcn_readfirstlane(t[2 * i + 1]); return (const float*)(((unsigned long long)hi << 32) | lo); }
};
#define WSP(T, off) ((T*)(F.ws + (off)))
#define LDS_WAIT() asm volatile("s_waitcnt lgkmcnt(0)" ::: "memory")
#define VM_WAIT() asm volatile("s_waitcnt vmcnt(0)" ::: "memory")
enum { I_X = 0, I_META, I_ABWIN, I_LOGDT, I_LRE, I_LIM, I_BRE, I_BIM, I_CRE, I_CIM, I_S5D, I_WGLU, I_GW2, I_GBG, I_GNG, I_ABWOUT, I_RWIN, I_RNG, I_RWOUT,
       I_LN1G, I_LN1B, I_LN2G, I_LN2B, I_ROUTER, I_MBIAS, I_MWG, I_MWU, I_MWD, I_SWG, I_SWU, I_SWD };

DI void p0_transpose_item(const float* W, int ldw, bf16* WT, int K, int k0, int n0, int drow0, LAS float* scr, int lane) {
#pragma unroll 8
    for (int i = 0; i < 32; ++i) { const int kk = 2 * i + (lane >> 5); scr[kk * 33 + (lane & 31)] = W[(size_t)(k0 + kk) * ldw + n0 + (lane & 31)]; }
    LDS_WAIT(); asm volatile("" ::: "memory");
    const int c = lane & 7;
#pragma unroll
    for (int j = 0; j < 4; ++j) { const int n = (lane >> 3) + 8 * j; const LAS float* s = scr + (8 * c) * 33 + n;
        u32x4 o; o.x = pk2(s[0 * 33], s[1 * 33]); o.y = pk2(s[2 * 33], s[3 * 33]); o.z = pk2(s[4 * 33], s[5 * 33]); o.w = pk2(s[6 * 33], s[7 * 33]);
        *(u32x4*)(WT + (size_t)(drow0 + n) * K + k0 + 8 * c) = o; }
    LDS_WAIT(); asm volatile("" ::: "memory");
}
DI void p0_dense_item(Frame& F, int it, LAS float* scr) {
    constexpr int C0 = 32 * 128, C1 = 16 * 32, C2 = 32 * 64, C3 = 32 * 384, C4 = 64 * 64;
    const float* W; int ldw, K, nblk; bf16* WT;
    if (it < C0) { W = F.inp(I_ABWIN); ldw = ABC; K = 2048; nblk = 128; WT = WSP(bf16, WS_WIN0T); }
    else if ((it -= C0) < C1) { W = F.inp(I_WGLU); ldw = 1024; K = 1024; nblk = 32; WT = WSP(bf16, WS_WGLUT); }
    else if ((it -= C1) < C2) { W = F.inp(I_ABWOUT); ldw = 2048; K = 2048; nblk = 64; WT = WSP(bf16, WS_WOUT0T); }
    else if ((it -= C2) < C3) { W = F.inp(I_RWIN); ldw = RETC; K = 2048; nblk = 384; WT = WSP(bf16, WS_WIN1T); }
    else { it -= C3; W = F.inp(I_RWOUT); ldw = 2048; K = 4096; nblk = 64; WT = WSP(bf16, WS_WOUT1T); }
    const int kb = it / nblk, nb = it % nblk;
    p0_transpose_item(W, ldw, WT, K, 64 * kb, 32 * nb, 32 * nb, scr, F.lane);
}
constexpr int P0_DENSE_ITEMS = 32 * 128 + 16 * 32 + 32 * 64 + 32 * 384 + 64 * 64;
constexpr int P0_MOE_ITEMS = 2 * NEX * 3 * 512;
DI void p0_moe_item(Frame& F, int it, LAS float* scr) {
    const int l = it / (NEX * 1536); int rem = it % (NEX * 1536); const int e = rem / 1536; rem %= 1536; const int mat = rem / 512, k = rem % 512;
    if (mat < 2) {
        const float* W = (e < NE) ? F.inp(mat == 0 ? I_MWG : I_MWU) + (size_t)(l * NE + e) * 2048 * 512 : F.inp(mat == 0 ? I_SWG : I_SWU) + (size_t)l * 2048 * 512;
        bf16* WT = WSP(bf16, WS_WGU) + (size_t)(l * NEX + e) * 1024 * 2048;
        const int kb = k / 16, nb = k % 16, n0 = 32 * nb;
        p0_transpose_item(W, 512, WT, 2048, 64 * kb, n0, (n0 >> 7) * 256 + mat * 128 + (n0 & 127), scr, F.lane);
    } else {
        const float* W = (e < NE) ? F.inp(I_MWD) + (size_t)(l * NE + e) * 512 * 2048 : F.inp(I_SWD) + (size_t)l * 512 * 2048;
        bf16* WT = WSP(bf16, WS_WD) + (size_t)(l * NEX + e) * 2048 * 512;
        const int kb = k / 64, nb = k % 64;
        p0_transpose_item(W, 2048, WT, 512, 64 * kb, 32 * nb, 32 * nb, scr, F.lane);
    }
}
DI void p0_s5_group(Frame& F, int g) {
    LAS f32x2* POW = (LAS f32x2*)(F.lds);
    LAS f32x2* BB = (LAS f32x2*)(F.lds + 9216);
    LAS f32x2* CC = (LAS f32x2*)(F.lds + 9216 + 8192);
    LAS float* KD = (LAS float*)(F.lds + 9216 + 16384);
    LAS f32x2* ZS = (LAS f32x2*)(F.lds + 9216 + 32768);
    const int tid = F.tid;
    if (tid < 64) {
        const int p = tid; const float dt = expf(F.inp(I_LOGDT)[g]); const float lr = F.inp(I_LRE)[g * 64 + p], li = F.inp(I_LIM)[g * 64 + p];
        for (int k = 0; k <= 16; ++k) { const float mag = expf(lr * dt * (float)k); float sn, cs; sincosf(li * dt * (float)k, &sn, &cs); POW[k * 64 + p] = (f32x2){mag * cs, mag * sn}; }
        const f32x2 ab = POW[64 + p]; const float nr = ab.x - 1.0f, ni = ab.y, den = lr * lr + li * li;
        ZS[p] = (f32x2){(nr * lr + ni * li) / den, (ni * lr - nr * li) / den};
        const f32x2 a16 = POW[16 * 64 + p]; float* o = WSP(float, WS_A16) + (size_t)(g * 64 + p) * 2; o[0] = a16.x; o[1] = a16.y;
    }
    __syncthreads();
    for (int e = tid; e < 1024; e += NTHR) {
        const int p = e >> 4, c = e & 15; const f32x2 z = ZS[p]; const float br = F.inp(I_BRE)[(size_t)(g * 64 + p) * 16 + c], bi = F.inp(I_BIM)[(size_t)(g * 64 + p) * 16 + c];
        BB[p * 16 + c] = (f32x2){z.x * br - z.y * bi, z.x * bi + z.y * br};
        const int c2 = e >> 6, p2 = e & 63;
        CC[c2 * 64 + p2] = (f32x2){F.inp(I_CRE)[(size_t)(g * 16 + c2) * 64 + p2], F.inp(I_CIM)[(size_t)(g * 16 + c2) * 64 + p2]};
    }
    __syncthreads();
    for (int e = tid; e < 4096; e += NTHR) {
        const int dl = e >> 8, c = (e >> 4) & 15, c2 = e & 15; float s = 0.f;
        for (int p = 0; p < 64; ++p) { const f32x2 cc = CC[c * 64 + p], pw = POW[dl * 64 + p], bb = BB[p * 16 + c2];
            const float wr_ = cc.x * pw.x - cc.y * pw.y, wi_ = cc.x * pw.y + cc.y * pw.x; s += wr_ * bb.x - wi_ * bb.y; }
        KD[e] = s;
    }
    __syncthreads();
    unsigned* TMo = WSP(unsigned, WS_TM) + (size_t)g * 256 * 192;
    for (int e = tid; e < 256 * 192; e += NTHR) {
        const int row = e / 192, kp = (e % 192) * 2, tau = row >> 4, c = row & 15; float v[2];
#pragma unroll
        for (int q = 0; q < 2; ++q) { const int k = kp + q;
            if (k < 256) { const int s = k >> 4, c2 = k & 15; v[q] = (s <= tau) ? KD[((tau - s) << 8) + (c << 4) + c2] + ((s == tau && c == c2) ? F.inp(I_S5D)[g * 16 + c] : 0.f) : 0.f; }
            else { const int j = k - 256, p = j & 63; const f32x2 cc = CC[c * 64 + p], pw = POW[(tau + 1) * 64 + p];
                v[q] = (j < 64) ? (cc.x * pw.x - cc.y * pw.y) : -(cc.x * pw.y + cc.y * pw.x); } }
        TMo[e] = pk2(v[0], v[1]);
    }
    unsigned* BKo = WSP(unsigned, WS_BKT) + (size_t)g * 128 * 128;
    for (int e = tid; e < 128 * 128; e += NTHR) {
        const int j = e >> 7, kp = (e & 127) * 2, p = j & 63; float v[2];
#pragma unroll
        for (int q = 0; q < 2; ++q) { const int k = kp + q, s = k >> 4, c = k & 15; const f32x2 pw = POW[(15 - s) * 64 + p], bb = BB[p * 16 + c];
            v[q] = (j < 64) ? (pw.x * bb.x - pw.y * bb.y) : (pw.x * bb.y + pw.y * bb.x); }
        BKo[e] = pk2(v[0], v[1]);
    }
    __syncthreads();
}
DI void p0_prologue(Frame& F) {
    if (F.bid < 64) p0_s5_group(F, F.bid);
    LAS float* scr = (LAS float*)(F.lds + F.wave * 16384);
    const int gw = F.bid * NWAVES + F.wave, NGW = F.G * NWAVES;
    for (int it = gw; it < P0_DENSE_ITEMS; it += NGW) p0_dense_item(F, it, scr);
    for (int it = gw; it < P0_MOE_ITEMS; it += NGW) p0_moe_item(F, it, scr);
    const size_t gt = (size_t)F.bid * NTHR + F.tid, NGT = (size_t)F.G * NTHR;
    for (size_t e = gt; e < 16 * 2048; e += NGT) { const int n = (int)(e >> 11), k = (int)(e & 2047); WSP(bf16, WS_WIN0T)[(size_t)(4096 + n) * 2048 + k] = f2bf(F.inp(I_ABWIN)[(size_t)k * ABC + 4096 + n]); }
    for (size_t e = gt; e < 2 * 64 * 2048; e += NGT) { const int l = (int)(e >> 17), n = (int)((e >> 11) & 63), k = (int)(e & 2047);
        const float w = F.inp(I_ROUTER)[((size_t)l * 2048 + k) * 64 + n]; const bf16 hi = f2bf(w); const bf16 lo = f2bf(w - bf2f(hi));
        WSP(bf16, WS_RT)[((size_t)(l * 2 + 0) * 64 + n) * 2048 + k] = hi; WSP(bf16, WS_RT)[((size_t)(l * 2 + 1) * 64 + n) * 2048 + k] = lo; }
    for (size_t e = gt; e < (size_t)TR * 512; e += NGT) { const size_t r = e >> 9, c4 = (e & 511) * 4;
        const f32x4 v = (r < TM) ? *(const f32x4*)(F.inp(I_X) + r * 2048 + c4) : *(const f32x4*)(F.inp(I_META) + (r - TM) * 2048 + c4);
        u32x2 o; o.x = pk2(v[0], v[1]); o.y = pk2(v[2], v[3]); *(u32x2*)(WSP(bf16, WS_XB) + r * 2048 + c4) = o; }
    for (size_t e = gt; e < (size_t)2064 * 128; e += NGT) { const int pos = (int)(e >> 7), j = (int)(e & 127);
        const float inv = exp2f(-(float)j * (13.287712379549449f / 128.0f)); float sn, cs; sincosf((float)pos * inv, &sn, &cs); WSP(f32x2, WS_ROPE)[e] = (f32x2){cs, sn}; }
}

DI f32x4 skinny_tile(const bf16* A0, size_t lda, const bf16* Bt, size_t ldb, int K, int lane) {
    const int r = lane & 15, q = lane >> 4;
    const bf16* ap = A0 + (size_t)r * lda + 8 * q; const bf16* bp = Bt + (size_t)r * ldb + 8 * q;
    f32x4 acc0 = {0.f, 0.f, 0.f, 0.f}, acc1 = {0.f, 0.f, 0.f, 0.f};
    for (int k = 0; k < K; k += 128) {
        const bf16x8 a0 = *(const bf16x8*)(ap + k), a1 = *(const bf16x8*)(ap + k + 32), a2 = *(const bf16x8*)(ap + k + 64), a3 = *(const bf16x8*)(ap + k + 96);
        const bf16x8 b0 = *(const bf16x8*)(bp + k), b1 = *(const bf16x8*)(bp + k + 32), b2 = *(const bf16x8*)(bp + k + 64), b3 = *(const bf16x8*)(bp + k + 96);
        acc0 = MFMA16(a0, b0, acc0); acc1 = MFMA16(a1, b1, acc1); acc0 = MFMA16(a2, b2, acc0); acc1 = MFMA16(a3, b3, acc1);
    }
    return acc0 + acc1;
}

DI void s5_unit(Frame& F, int b, int g) {
    LAS float* Gs = (LAS float*)(F.lds);
    LAS bf16* Hb = (LAS bf16*)(F.lds + 66048);
    const int w = F.wave, lane = F.lane, r = lane & 15, q = lane >> 4;
    const bf16* Ub = WSP(bf16, WS_U) + (size_t)(b * 64 + g) * 2048 * 16;
    const bf16* Um = WSP(bf16, WS_UMETA) + (size_t)g * 256;
    const bf16* BK = WSP(bf16, WS_BKT) + (size_t)g * 128 * 256;
    const bf16* TMg = WSP(bf16, WS_TM) + (size_t)g * 256 * 384;
    {
        f32x4 acc[8], accm[8];
#pragma unroll
        for (int n = 0; n < 8; ++n) { acc[n] = (f32x4){0.f, 0.f, 0.f, 0.f}; accm[n] = (f32x4){0.f, 0.f, 0.f, 0.f}; }
#pragma unroll 2
        for (int ks = 0; ks < 8; ++ks) {
            const bf16x8 a = *(const bf16x8*)(Ub + (size_t)(16 * w + r) * 256 + 32 * ks + 8 * q);
            const bf16x8 am = *(const bf16x8*)(Um + 32 * ks + 8 * q);
#pragma unroll
            for (int n = 0; n < 8; ++n) { const bf16x8 bb = *(const bf16x8*)(BK + (size_t)(16 * n + r) * 256 + 32 * ks + 8 * q);
                acc[n] = MFMA16(a, bb, acc[n]); if (w == 0) accm[n] = MFMA16(am, bb, accm[n]); }
        }
#pragma unroll
        for (int n = 0; n < 8; ++n) {
#pragma unroll
            for (int i = 0; i < 4; ++i) Gs[(16 * w + 4 * q + i) * 128 + 16 * n + r] = acc[n][i];
            if (w == 0 && q == 0) Gs[128 * 128 + 16 * n + r] = accm[n][0];
        }
    }
    __syncthreads();
    if (w == 0) {
        const int p = lane; const float ar = WSP(float, WS_A16)[(size_t)(g * 64 + p) * 2], ai = WSP(float, WS_A16)[(size_t)(g * 64 + p) * 2 + 1];
        float hr = Gs[128 * 128 + p], hi = Gs[128 * 128 + 64 + p];
        for (int n = 0; n < 128; ++n) {
            Hb[n * 128 + p] = f2bf(hr); Hb[n * 128 + 64 + p] = f2bf(hi);
            const float gr = Gs[n * 128 + p], gi = Gs[n * 128 + 64 + p];
            const float nr = ar * hr - ai * hi + gr, ni = ar * hi + ai * hr + gi; hr = nr; hi = ni;
        }
    } else {
        for (int e = (w - 1) * 64 + lane; e < 16 * 128; e += 7 * 64) Hb[128 * 128 + e] = 0;
    }
    __syncthreads();
    bf16* Zo = WSP(bf16, WS_Z);
#pragma unroll 1
    for (int pass = 0; pass < (b == 0 ? 3 : 2); ++pass) {
        const bool meta = pass == 2; const int nbase = meta ? 2 * w : 8 * pass, ncnt = meta ? 2 : 8;
        f32x4 acc[8];
#pragma unroll
        for (int n = 0; n < 8; ++n) acc[n] = (f32x4){0.f, 0.f, 0.f, 0.f};
        const int arow = meta ? 128 + r : 16 * w + r;
#pragma unroll 2
        for (int ks = 0; ks < 12; ++ks) {
            bf16x8 a;
            if (ks < 8) a = meta ? *(const bf16x8*)(Um + 32 * ks + 8 * q) : *(const bf16x8*)(Ub + (size_t)arow * 256 + 32 * ks + 8 * q);
            else a = *(const LAS bf16x8*)(Hb + arow * 128 + 32 * (ks - 8) + 8 * q);
#pragma unroll
            for (int n = 0; n < 8; ++n) if (n < ncnt) { const bf16x8 bb = *(const bf16x8*)(TMg + (size_t)(16 * (nbase + n) + r) * 384 + 32 * ks + 8 * q); acc[n] = MFMA16(a, bb, acc[n]); }
        }
#pragma unroll
        for (int n = 0; n < 8; ++n) if (n < ncnt) {
            const int tau = nbase + n;
            if (!meta) {
#pragma unroll
                for (int i = 0; i < 4; ++i) Zo[((size_t)b * 2048 + 16 * (16 * w + 4 * q + i) + tau) * 1024 + g * 16 + r] = f2bf(gelu_tanh(acc[n][i]));
            } else if (q == 0) Zo[((size_t)TM + tau) * 1024 + g * 16 + r] = f2bf(gelu_tanh(acc[n][0]));
        }
    }
    __syncthreads();
}

DI float logsig16(float x) { return (fminf(x, 0.f) - log1pf(__expf(-fabsf(x)))) * 0.0625f; }
DI void gla_pre_unit(Frame& F, int b, int n, int h) {
    LAS float* GLs = (LAS float*)(F.lds);
    LAS float* W2s = (LAS float*)(F.lds + 4096);
    LAS float* CAR = (LAS float*)(F.lds + 12288);
    LAS bf16* KnT = (LAS bf16*)(F.lds + 16384);
    const int tid = F.tid, j = tid & 127, tq = tid >> 7;
    const size_t row0 = (size_t)b * 2048 + 64 * n;
    for (int e = tid; e < 1024; e += NTHR) GLs[e] = WSP(float, WS_GL)[row0 * 16 + e];
    for (int e = tid; e < 2048; e += NTHR) W2s[e] = F.inp(I_GW2)[(size_t)(e >> 7) * 512 + h * 128 + (e & 127)];
    const float bias = F.inp(I_GBG)[h * 128 + j];
    __syncthreads();
    float bl[16]; float run = 0.f;
#pragma unroll
    for (int i = 0; i < 16; ++i) { const int t = tq * 16 + i; float x = bias;
#pragma unroll
        for (int rr = 0; rr < 16; ++rr) x += GLs[t * 16 + rr] * W2s[rr * 128 + j];
        run += logsig16(x); bl[i] = run; }
    CAR[tq * 128 + j] = run;
    __syncthreads();
    float off = 0.f, tot = 0.f;
#pragma unroll
    for (int t2 = 0; t2 < 4; ++t2) { const float c = CAR[t2 * 128 + j]; tot += c; off += (t2 < tq) ? c : 0.f; }
    const bf16* Qr = WSP(bf16, WS_QRAW); const bf16* Kr = WSP(bf16, WS_KRAW); bf16* QSo = WSP(bf16, WS_QS); bf16* KNo = WSP(bf16, WS_KN);
    float kn[16];
#pragma unroll
    for (int i = 0; i < 16; ++i) { const size_t row = row0 + tq * 16 + i; const float bb = bl[i] + off, e = __expf(bb), ei = __expf(-bb);
        const float qv = bf2f(Qr[row * 512 + h * 128 + j]), kv = bf2f(Kr[row * 512 + h * 128 + j]);
        QSo[row * 512 + h * 128 + j] = f2bf(qv * e); kn[i] = kv * ei; KNo[row * 512 + h * 128 + j] = f2bf(kn[i]); }
    { u32x4 o0, o1; o0.x = pk2(kn[0], kn[1]); o0.y = pk2(kn[2], kn[3]); o0.z = pk2(kn[4], kn[5]); o0.w = pk2(kn[6], kn[7]);
      o1.x = pk2(kn[8], kn[9]); o1.y = pk2(kn[10], kn[11]); o1.z = pk2(kn[12], kn[13]); o1.w = pk2(kn[14], kn[15]);
      *(LAS u32x4*)(KnT + j * 64 + tq * 16) = o0; *(LAS u32x4*)(KnT + j * 64 + tq * 16 + 8) = o1; }
    if (tq == 0) WSP(float, WS_DC0)[(size_t)(b * 32 + n) * 512 + h * 128 + j] = __expf(tot);
    __syncthreads();
    {
        const int w = F.wave, lane = F.lane, r = lane & 15, q = lane >> 4;
        const bf16* VT = WSP(bf16, WS_VT0) + ((size_t)(b * 1024 + h * 256) * 2048 + 64 * n);
        bf16* STo = WSP(bf16, WS_ST0) + (size_t)((b * 4 + h) * 32 + n) * 256 * 128;
#pragma unroll
        for (int mi = 0; mi < 2; ++mi) {
            const int mt = 2 * w + mi;
            f32x4 acc[8];
#pragma unroll
            for (int nn = 0; nn < 8; ++nn) acc[nn] = (f32x4){0.f, 0.f, 0.f, 0.f};
#pragma unroll
            for (int ks = 0; ks < 2; ++ks) {
                const bf16x8 a = *(const bf16x8*)(VT + (size_t)(16 * mt + r) * 2048 + 32 * ks + 8 * q);
#pragma unroll
                for (int nn = 0; nn < 8; ++nn) { const bf16x8 bb = *(const LAS bf16x8*)(KnT + (16 * nn + r) * 64 + 32 * ks + 8 * q); acc[nn] = MFMA16(a, bb, acc[nn]); }
            }
#pragma unroll
            for (int nn = 0; nn < 8; ++nn)
#pragma unroll
                for (int i = 0; i < 4; ++i) STo[(size_t)(16 * mt + 4 * q + i) * 128 + 16 * nn + r] = f2bf(acc[nn][i]);
        }
    }
    __syncthreads();
}
DI void gla_meta_unit(Frame& F, int h) {
    LAS float* GLs = (LAS float*)(F.lds);
    LAS float* W2s = (LAS float*)(F.lds + 4096);
    LAS float* QSm = (LAS float*)(F.lds + 16384);
    LAS float* KNm = (LAS float*)(F.lds + 24576);
    LAS float* Vm = (LAS float*)(F.lds + 32768);
    LAS float* SC = (LAS float*)(F.lds + 49152);
    LAS float* Om = (LAS float*)(F.lds + 53248);
    LAS float* DCm = (LAS float*)(F.lds + 69632);
    const int tid = F.tid, j = tid & 127, tq = tid >> 7;
    const float* PM = WSP(float, WS_PMETA);
    for (int e = tid; e < 256; e += NTHR) GLs[e] = WSP(float, WS_GL)[(size_t)TM * 16 + e];
    for (int e = tid; e < 2048; e += NTHR) W2s[e] = F.inp(I_GW2)[(size_t)(e >> 7) * 512 + h * 128 + (e & 127)];
    for (int e = tid; e < 4096; e += NTHR) Vm[e] = PM[(size_t)(e >> 8) * ABC + 2048 + h * 256 + (e & 255)];
    __syncthreads();
    if (tq == 0) {
        const float bias = F.inp(I_GBG)[h * 128 + j]; float run = 0.f;
        for (int i = 0; i < 16; ++i) { float x = bias;
#pragma unroll
            for (int rr = 0; rr < 16; ++rr) x += GLs[i * 16 + rr] * W2s[rr * 128 + j];
            run += logsig16(x);
            QSm[i * 128 + j] = PM[(size_t)i * ABC + 1024 + h * 128 + j] * 0.08838834764831845f * __expf(run);
            KNm[i * 128 + j] = PM[(size_t)i * ABC + 1536 + h * 128 + j] * __expf(-run); }
        DCm[j] = __expf(run);
    }
    __syncthreads();
    {
        const float dc = DCm[j]; float* So = WSP(float, WS_SMETA0) + (size_t)h * 256 * 128;
        for (int d = 0; d < 64; ++d) { const int dv = tq * 64 + d; float s = 0.f;
#pragma unroll
            for (int i = 0; i < 16; ++i) s += KNm[i * 128 + j] * Vm[i * 256 + dv];
            So[(size_t)dv * 128 + j] = dc * s; }
    }
    if (tid < 256) { const int i = tid >> 4, s = tid & 15; float a = 0.f; for (int jj = 0; jj < 128; ++jj) a += QSm[i * 128 + jj] * KNm[s * 128 + jj]; SC[tid] = (s <= i) ? a : 0.f; }
    __syncthreads();
    { const int dv = tid & 255, ih = tid >> 8;
        for (int i2 = 0; i2 < 8; ++i2) { const int i = ih * 8 + i2; float o = 0.f;
#pragma unroll
            for (int s = 0; s < 16; ++s) o += SC[i * 16 + s] * Vm[s * 256 + dv];
            Om[i * 256 + dv] = o; } }
    __syncthreads();
    for (int rr = 0; rr < 2; ++rr) {
        const int i = F.wave * 2 + rr; float v[4], s = 0.f;
#pragma unroll
        for (int k = 0; k < 4; ++k) { v[k] = Om[i * 256 + F.lane + 64 * k]; s += v[k]; }
        const float mean = wave_sum(s) * (1.f / 256.f); float s2 = 0.f;
#pragma unroll
        for (int k = 0; k < 4; ++k) { v[k] -= mean; s2 += v[k] * v[k]; }
        const float rstd = 1.f / sqrtf(wave_sum(s2) * (1.f / 256.f) + LN_EPS);
#pragma unroll
        for (int k = 0; k < 4; ++k) { const int dv = F.lane + 64 * k;
            const float gate = siluf_(PM[(size_t)i * ABC + 3072 + h * 256 + dv]);
            WSP(bf16, WS_MIXED0)[(size_t)(TM + i) * 2048 + 1024 + h * 256 + dv] = f2bf(v[k] * rstd * F.inp(I_GNG)[h * 256 + dv] * gate); }
    }
    __syncthreads();
}
DI void gla_scan(Frame& F) {
    const size_t gt = (size_t)F.bid * NTHR + F.tid, NGT = (size_t)F.G * NTHR;
    for (size_t e = gt; e < (size_t)16 * 256 * 32; e += NGT) {
        const int bh = (int)(e >> 13), dv = (int)((e >> 5) & 255), dk = (int)(e & 31) * 4, b = bh >> 2, h = bh & 3;
        f32x4 s = *(const f32x4*)(WSP(float, WS_SMETA0) + ((size_t)h * 256 + dv) * 128 + dk);
        bf16* st = WSP(bf16, WS_ST0) + ((size_t)bh * 32 * 256 + dv) * 128 + dk;
        const float* dcp = WSP(float, WS_DC0) + (size_t)b * 32 * 512 + h * 128 + dk;
        for (int n = 0; n < 32; ++n) {
            u32x2* p = (u32x2*)(st + (size_t)n * 256 * 128); const u32x2 c = *p; const f32x4 dc = *(const f32x4*)(dcp + (size_t)n * 512);
            u32x2 o; o.x = pk2(s[0], s[1]); o.y = pk2(s[2], s[3]); *p = o;
            s[0] = dc[0] * (s[0] + bflo(c.x)); s[1] = dc[1] * (s[1] + bfhi(c.x)); s[2] = dc[2] * (s[2] + bflo(c.y)); s[3] = dc[3] * (s[3] + bfhi(c.y));
        }
    }
}
DI void gla_out_unit(Frame& F, int b, int n, int h) {
    LAS float* STA = (LAS float*)(F.lds);
    const int w = F.wave, lane = F.lane, r = lane & 15, q = lane >> 4, rb = w & 3, dh = w >> 2;
    const size_t row0 = (size_t)b * 2048 + 64 * n;
    const bf16* QSp = WSP(bf16, WS_QS) + row0 * 512 + h * 128; const bf16* KNp = WSP(bf16, WS_KN) + row0 * 512 + h * 128;
    const bf16* VT = WSP(bf16, WS_VT0) + ((size_t)(b * 1024 + h * 256 + dh * 128) * 2048 + 64 * n);
    const bf16* STp = WSP(bf16, WS_ST0) + ((size_t)((b * 4 + h) * 32 + n) * 256 + dh * 128) * 128;
    bf16x8 qf[4];
#pragma unroll
    for (int ks = 0; ks < 4; ++ks) qf[ks] = *(const bf16x8*)(QSp + (size_t)(16 * rb + r) * 512 + 32 * ks + 8 * q);
    f32x4 PT[4];
#pragma unroll
    for (int kb = 0; kb < 4; ++kb) { PT[kb] = (f32x4){0.f, 0.f, 0.f, 0.f};
        if (kb <= rb) {
#pragma unroll
            for (int ks = 0; ks < 4; ++ks) { const bf16x8 kf = *(const bf16x8*)(KNp + (size_t)(16 * kb + r) * 512 + 32 * ks + 8 * q); PT[kb] = MFMA16(kf, qf[ks], PT[kb]); }
            if (kb == rb) {
#pragma unroll
                for (int i = 0; i < 4; ++i) PT[kb][i] = (4 * q + i <= r) ? PT[kb][i] : 0.f; }
        } }
    f32x4 acc[8];
#pragma unroll
    for (int nn = 0; nn < 8; ++nn) acc[nn] = (f32x4){0.f, 0.f, 0.f, 0.f};
#pragma unroll
    for (int ks = 0; ks < 4; ++ks)
#pragma unroll
        for (int nn = 0; nn < 8; ++nn) { const bf16x8 sf = *(const bf16x8*)(STp + (size_t)(16 * nn + r) * 128 + 32 * ks + 8 * q); acc[nn] = MFMA16(qf[ks], sf, acc[nn]); }
#pragma unroll
    for (int s2 = 0; s2 < 2; ++s2) if (2 * s2 <= rb) {
        u32x4 pa; pa.x = pk2(PT[2 * s2][0], PT[2 * s2][1]); pa.y = pk2(PT[2 * s2][2], PT[2 * s2][3]); pa.z = pk2(PT[2 * s2 + 1][0], PT[2 * s2 + 1][1]); pa.w = pk2(PT[2 * s2 + 1][2], PT[2 * s2 + 1][3]);
        const bf16x8 af = __builtin_bit_cast(bf16x8, pa);
#pragma unroll
        for (int nn = 0; nn < 8; ++nn) { const bf16* vp = VT + (size_t)(16 * nn + r) * 2048 + 32 * s2 + 4 * q;
            const u32x2 v0 = *(const u32x2*)vp, v1 = *(const u32x2*)(vp + 16); u32x4 vb; vb.x = v0.x; vb.y = v0.y; vb.z = v1.x; vb.w = v1.y;
            acc[nn] = MFMA16(af, __builtin_bit_cast(bf16x8, vb), acc[nn]); }
    }
    float sm[4], sq[4];
#pragma unroll
    for (int i = 0; i < 4; ++i) { float a = 0.f, c = 0.f;
#pragma unroll
        for (int nn = 0; nn < 8; ++nn) { a += acc[nn][i]; c += acc[nn][i] * acc[nn][i]; }
#pragma unroll
        for (int o = 1; o < 16; o <<= 1) { a += __shfl_xor(a, o); c += __shfl_xor(c, o); }
        sm[i] = a; sq[i] = c; }
    if (r == 0) {
#pragma unroll
        for (int i = 0; i < 4; ++i) { STA[(dh * 64 + 16 * rb + 4 * q + i) * 2] = sm[i]; STA[(dh * 64 + 16 * rb + 4 * q + i) * 2 + 1] = sq[i]; } }
    __syncthreads();
    const bf16* Rp = WSP(bf16, WS_R); bf16* MX = WSP(bf16, WS_MIXED0);
#pragma unroll
    for (int i = 0; i < 4; ++i) {
        const int rl = 16 * rb + 4 * q + i; const float s = STA[rl * 2] + STA[(64 + rl) * 2], s2 = STA[rl * 2 + 1] + STA[(64 + rl) * 2 + 1];
        const float mean = s * (1.f / 256.f), var = fmaxf(s2 * (1.f / 256.f) - mean * mean, 0.f), rstd = 1.f / sqrtf(var + LN_EPS);
        const size_t row = row0 + rl;
#pragma unroll
        for (int nn = 0; nn < 8; ++nn) { const int dv = h * 256 + dh * 128 + 16 * nn + r;
            MX[row * 2048 + 1024 + dv] = f2bf((acc[nn][i] - mean) * rstd * F.inp(I_GNG)[dv] * bf2f(Rp[row * 1024 + dv])); }
    }
    __syncthreads();
}
DI void p1_skinny(Frame& F) {
    const int gw = F.bid * NWAVES + F.wave, NGW = F.G * NWAVES, lane = F.lane, c = lane & 15, q = lane >> 4;
    const bf16* XB = WSP(bf16, WS_XB); const bf16* WT = WSP(bf16, WS_WIN0T);
    for (int t = gw; t < 257 + 512; t += NGW) {
        if (t < 257) {
            const f32x4 a = skinny_tile(XB + (size_t)TM * 2048, 2048, WT + (size_t)t * 16 * 2048, 2048, 2048, lane);
#pragma unroll
            for (int i = 0; i < 4; ++i) { const int tok = 4 * q + i; WSP(float, WS_PMETA)[(size_t)tok * ABC + t * 16 + c] = a[i];
                if (t < 64) WSP(bf16, WS_UMETA)[(size_t)(t * 16 + tok) * 16 + c] = f2bf(a[i]);
                if (t == 256) WSP(float, WS_GL)[(size_t)(TM + tok) * 16 + c] = a[i]; }
        } else {
            const int rbk = t - 257;
            const f32x4 a = skinny_tile(XB + (size_t)rbk * 16 * 2048, 2048, WT + (size_t)4096 * 2048, 2048, 2048, lane);
#pragma unroll
            for (int i = 0; i < 4; ++i) WSP(float, WS_GL)[(size_t)(rbk * 16 + 4 * q + i) * 16 + c] = a[i];
        }
    }
}
DI void glu_meta_skinny(Frame& F) {
    const int gw = F.bid * NWAVES + F.wave, NGW = F.G * NWAVES, lane = F.lane, c = lane & 15, q = lane >> 4;
    const bf16* Z = WSP(bf16, WS_Z);
    for (int t = gw; t < 64; t += NGW) {
        const f32x4 a = skinny_tile(Z + (size_t)TM * 1024, 1024, WSP(bf16, WS_WGLUT) + (size_t)t * 16 * 1024, 1024, 1024, lane);
#pragma unroll
        for (int i = 0; i < 4; ++i) { const size_t row = TM + 4 * q + i; const int col = t * 16 + c;
            WSP(bf16, WS_MIXED0)[row * 2048 + col] = f2bf(bf2f(Z[row * 1024 + col]) * sigmoidf_(a[i])); }
    }
}
DI void out0_meta_skinny(Frame& F) {
    const int gw = F.bid * NWAVES + F.wave, NGW = F.G * NWAVES, lane = F.lane, c = lane & 15, q = lane >> 4;
    for (int t = gw; t < 128; t += NGW) {
        const f32x4 a = skinny_tile(WSP(bf16, WS_MIXED0) + (size_t)TM * 2048, 2048, WSP(bf16, WS_WOUT0T) + (size_t)t * 16 * 2048, 2048, 2048, lane);
#pragma unroll
        for (int i = 0; i < 4; ++i) { const int tok = 4 * q + i, col = t * 16 + c; WSP(float, WS_Y0)[(size_t)(TM + tok) * 2048 + col] = a[i] + ALPHA * F.inp(I_META)[(size_t)tok * 2048 + col]; }
    }
}
DI void kv1_meta_skinny(Frame& F) {
    const int gw = F.bid * NWAVES + F.wave, NGW = F.G * NWAVES, lane = F.lane, c = lane & 15, q = lane >> 4;
    for (int t = gw; t < 384; t += NGW) {
        const f32x4 a = skinny_tile(WSP(bf16, WS_H2B) + (size_t)TM * 2048, 2048, WSP(bf16, WS_WIN1T) + (size_t)(2048 + t * 16) * 2048, 2048, 2048, lane);
#pragma unroll
        for (int i = 0; i < 4; ++i) WSP(float, WS_KVMETA)[(size_t)(4 * q + i) * 6144 + t * 16 + c] = a[i];
    }
}

DI void ln_router_phase(Frame& F, int l, int ntok) {
    const int gw = F.bid * NWAVES + F.wave, NGW = F.G * NWAVES, lane = F.lane, r = lane & 15, q = lane >> 4;
    LAS float* Ss = (LAS float*)(F.lds + F.wave * 8192);
    LAS float* SBs = (LAS float*)(F.lds + F.wave * 8192 + 4096);
    LAS float* GSs = (LAS float*)(F.lds + 65536 + F.wave * 512);
    const float* Y0 = WSP(float, WS_Y0); float* H1F = WSP(float, WS_H1F); bf16* H1B = WSP(bf16, WS_H1B);
    const float* gam = F.inp(I_LN1G) + (size_t)l * 2048; const float* bet = F.inp(I_LN1B) + (size_t)l * 2048;
    const bf16* RH = WSP(bf16, WS_RT) + (size_t)(l * 2 + 0) * 64 * 2048; const bf16* RL = WSP(bf16, WS_RT) + (size_t)(l * 2 + 1) * 64 * 2048;
    unsigned* cnt = WSP(unsigned, WS_CTL) + CW_CNT + 128 * l;
    int* ROWIDX = WSP(int, WS_ROWIDX); int* EIDX = WSP(int, WS_ROUTE); int* EPOS = EIDX + TR * 8; float* EW = (float*)(EPOS + TR * 8);
    for (int t = gw; t * 16 < ntok; t += NGW) {
        for (int rr = 0; rr < 16; ++rr) {
            const size_t row = (size_t)t * 16 + rr;
            const f32x4* xr = (const f32x4*)(Y0 + row * 2048) + lane; f32x4 v[8]; float s = 0.f;
#pragma unroll
            for (int k = 0; k < 8; ++k) { v[k] = xr[64 * k]; s += (v[k][0] + v[k][1]) + (v[k][2] + v[k][3]); }
            const float mean = wave_sum(s) * (1.f / 2048.f); float s2 = 0.f;
#pragma unroll
            for (int k = 0; k < 8; ++k) { v[k] = v[k] - mean; s2 += (v[k][0] * v[k][0] + v[k][1] * v[k][1]) + (v[k][2] * v[k][2] + v[k][3] * v[k][3]); }
            const float rstd = 1.f / sqrtf(wave_sum(s2) * (1.f / 2048.f) + LN_EPS);
#pragma unroll
            for (int k = 0; k < 8; ++k) { const f32x4 g4 = *((const f32x4*)gam + lane + 64 * k), b4 = *((const f32x4*)bet + lane + 64 * k);
                const f32x4 y = v[k] * rstd * g4 + b4; *((f32x4*)(H1F + row * 2048) + lane + 64 * k) = y;
                u32x2 o; o.x = pk2(y[0], y[1]); o.y = pk2(y[2], y[3]); *((u32x2*)(H1B + row * 2048) + lane + 64 * k) = o; }
        }
        VM_WAIT(); asm volatile("" ::: "memory");
        f32x4 acc[4];
#pragma unroll
        for (int n = 0; n < 4; ++n) acc[n] = (f32x4){0.f, 0.f, 0.f, 0.f};
        const float* ap = H1F + ((size_t)t * 16 + r) * 2048 + 8 * q;
        for (int ks = 0; ks < 64; ++ks) {
            const f32x4 x0 = *(const f32x4*)(ap + 32 * ks), x1 = *(const f32x4*)(ap + 32 * ks + 4);
            u32x4 hi, lo;
            hi.x = pk2(x0[0], x0[1]); hi.y = pk2(x0[2], x0[3]); hi.z = pk2(x1[0], x1[1]); hi.w = pk2(x1[2], x1[3]);
            lo.x = pk2(x0[0] - bflo(hi.x), x0[1] - bfhi(hi.x)); lo.y = pk2(x0[2] - bflo(hi.y), x0[3] - bfhi(hi.y));
            lo.z = pk2(x1[0] - bflo(hi.z), x1[1] - bfhi(hi.z)); lo.w = pk2(x1[2] - bflo(hi.w), x1[3] - bfhi(hi.w));
            const bf16x8 ah = __builtin_bit_cast(bf16x8, hi), al = __builtin_bit_cast(bf16x8, lo);
#pragma unroll
            for (int n = 0; n < 4; ++n) { const bf16x8 bh = *(const bf16x8*)(RH + (size_t)(16 * n + r) * 2048 + 32 * ks + 8 * q), bl = *(const bf16x8*)(RL + (size_t)(16 * n + r) * 2048 + 32 * ks + 8 * q);
                acc[n] = MFMA16(ah, bh, acc[n]); acc[n] = MFMA16(al, bh, acc[n]); acc[n] = MFMA16(ah, bl, acc[n]); }
        }
#pragma unroll
        for (int n = 0; n < 4; ++n)
#pragma unroll
            for (int i = 0; i < 4; ++i) { const int e = 16 * n + r; const float s = sigmoidf_(acc[n][i]); Ss[(4 * q + i) * 64 + e] = s; SBs[(4 * q + i) * 64 + e] = s + F.inp(I_MBIAS)[l * 64 + e]; }
        LDS_WAIT(); asm volatile("" ::: "memory");
        {
            const int row = t * 16 + r;
#pragma unroll
            for (int gg = 0; gg < 2; ++gg) { float m1 = -INFINITY, m2 = -INFINITY;
                for (int k = 0; k < 8; ++k) { const float x = SBs[r * 64 + 16 * q + 8 * gg + k]; if (x > m1) { m2 = m1; m1 = x; } else if (x > m2) m2 = x; }
                GSs[r * 8 + 2 * q + gg] = m1 + m2; }
            LDS_WAIT(); asm volatile("" ::: "memory");
            float gs[8];
#pragma unroll
            for (int k = 0; k < 8; ++k) gs[k] = GSs[r * 8 + k];
            bool gsel[2];
#pragma unroll
            for (int gg = 0; gg < 2; ++gg) { const int gi = 2 * q + gg; int rank = 0; float mine = 0.f;
#pragma unroll
                for (int k = 0; k < 8; ++k) mine = (k == gi) ? gs[k] : mine;
#pragma unroll
                for (int k = 0; k < 8; ++k) rank += (gs[k] > mine || (gs[k] == mine && k < gi)) ? 1 : 0;
                gsel[gg] = rank < 4; }
#pragma unroll
            for (int gg = 0; gg < 2; ++gg) if (!gsel[gg]) { for (int k = 0; k < 8; ++k) SBs[r * 64 + 16 * q + 8 * gg + k] = -INFINITY; }
            LDS_WAIT(); asm volatile("" ::: "memory");
            int me0 = 0, me1 = 0; float mw0 = 0.f, mw1 = 0.f, wsum = 0.f;
            for (int kk = 0; kk < 8; ++kk) {
                float bv = -INFINITY; int bi = 16 * q;
                for (int k = 0; k < 16; ++k) { const float x = SBs[r * 64 + 16 * q + k]; if (x > bv) { bv = x; bi = 16 * q + k; } }
#pragma unroll
                for (int o = 16; o < 64; o <<= 1) { const float ov = __shfl_xor(bv, o); const int oi = __shfl_xor(bi, o); if (ov > bv || (ov == bv && oi < bi)) { bv = ov; bi = oi; } }
                const float wv = Ss[r * 64 + bi]; wsum += wv;
                if ((bi >> 4) == q) SBs[r * 64 + bi] = -INFINITY;
                if ((kk >> 1) == q) { if (kk & 1) { me1 = bi; mw1 = wv; } else { me0 = bi; mw0 = wv; } }
                LDS_WAIT(); asm volatile("" ::: "memory");
            }
            if (row < ntok) {
                const float sc = 2.5f / wsum;
                const unsigned p0 = atomicAdd(cnt + me0, 1u), p1 = atomicAdd(cnt + me1, 1u);
                ROWIDX[(size_t)me0 * TRP + p0] = row; ROWIDX[(size_t)me1 * TRP + p1] = row;
                EIDX[row * 8 + 2 * q] = me0; EIDX[row * 8 + 2 * q + 1] = me1; EPOS[row * 8 + 2 * q] = (int)p0; EPOS[row * 8 + 2 * q + 1] = (int)p1;
                EW[row * 8 + 2 * q] = mw0 * sc; EW[row * 8 + 2 * q + 1] = mw1 * sc;
                if (q == 0) ROWIDX[(size_t)NE * TRP + row] = row;
            }
        }
        LDS_WAIT(); asm volatile("" ::: "memory");
    }
}
DI void moe_tables(Frame& F, int l, int ntok, volatile LAS int* TP, volatile LAS int* CN) {
    if (F.tid < NEX) CN[F.tid] = (F.tid < NE) ? (int)__hip_atomic_load(WSP(unsigned, WS_CTL) + CW_CNT + 128 * l + F.tid, RLX_AGENT) : ntok;
    __syncthreads();
    if (F.tid == 0) { int a = 0; for (int e = 0; e < NEX; ++e) { TP[e] = a; a += (CN[e] + 255) >> 8; } TP[NEX] = a; }
    __syncthreads();
}
DI void combine_ln_phase(Frame& F, int l, int ntok, volatile LAS int* TP) {
    const int gw = F.bid * NWAVES + F.wave, NGW = F.G * NWAVES, lane = F.lane;
    const float* H1F = WSP(float, WS_H1F); const bf16* YB = WSP(bf16, WS_YBUF);
    const int* EIDX = WSP(int, WS_ROUTE); const int* EPOS = EIDX + TR * 8; const float* EW = (const float*)(EPOS + TR * 8);
    const float* gam = F.inp(I_LN2G) + (size_t)l * 2048; const float* bet = F.inp(I_LN2B) + (size_t)l * 2048;
    for (int row = gw; row < ntok; row += NGW) {
        f32x4 v[8];
#pragma unroll
        for (int k = 0; k < 8; ++k) v[k] = ALPHA * *((const f32x4*)(H1F + (size_t)row * 2048) + lane + 64 * k);
        for (int kk = 0; kk < 9; ++kk) {
            int slot; float w;
            if (kk < 8) { const int e = EIDX[row * 8 + kk]; slot = TP[e] * 256 + EPOS[row * 8 + kk]; w = EW[row * 8 + kk]; } else { slot = TP[NE] * 256 + row; w = 1.f; }
            const u32x2* yp = (const u32x2*)(YB + (size_t)slot * 2048) + lane;
#pragma unroll
            for (int k = 0; k < 8; ++k) { const u32x2 y = yp[64 * k]; v[k][0] += w * bflo(y.x); v[k][1] += w * bfhi(y.x); v[k][2] += w * bflo(y.y); v[k][3] += w * bfhi(y.y); }
        }
        float s = 0.f;
#pragma unroll
        for (int k = 0; k < 8; ++k) s += (v[k][0] + v[k][1]) + (v[k][2] + v[k][3]);
        const float mean = wave_sum(s) * (1.f / 2048.f); float s2 = 0.f;
#pragma unroll
        for (int k = 0; k < 8; ++k) { v[k] = v[k] - mean; s2 += (v[k][0] * v[k][0] + v[k][1] * v[k][1]) + (v[k][2] * v[k][2] + v[k][3] * v[k][3]); }
        const float rstd = 1.f / sqrtf(wave_sum(s2) * (1.f / 2048.f) + LN_EPS);
#pragma unroll
        for (int k = 0; k < 8; ++k) { const f32x4 g4 = *((const f32x4*)gam + lane + 64 * k), b4 = *((const f32x4*)bet + lane + 64 * k);
            const f32x4 y = v[k] * rstd * g4 + b4;
            if (l == 0) { *((f32x4*)(WSP(float, WS_H2F) + (size_t)row * 2048) + lane + 64 * k) = y;
                u32x2 o; o.x = pk2(y[0], y[1]); o.y = pk2(y[2], y[3]); *((u32x2*)(WSP(bf16, WS_H2B) + (size_t)row * 2048) + lane + 64 * k) = o; }
            else *((f32x4*)(F.out + (size_t)row * 2048) + lane + 64 * k) = y; }
    }
}
DI void ret_scan(Frame& F) {
    const size_t gt = (size_t)F.bid * NTHR + F.tid, NGT = (size_t)F.G * NTHR;
    const float* KV = WSP(float, WS_KVMETA); const f32x2* rope = WSP(f32x2, WS_ROPE);
    for (size_t e = gt; e < (size_t)32 * 512 * 32; e += NGT) {
        const int bh = (int)(e >> 14), dv = (int)((e >> 5) & 511), dk0 = (int)(e & 31) * 8, h = bh & 7;
        const float l2g = lg2gamma(h), g256 = exp2f(256.f * l2g);
        float s[8];
#pragma unroll
        for (int i = 0; i < 8; ++i) s[i] = 0.f;
        for (int m = 0; m < 16; ++m) {
            const float vm = KV[(size_t)m * 6144 + 2048 + h * 512 + dv] * 0.0625f * exp2f((float)(15 - m) * l2g);
#pragma unroll
            for (int i = 0; i < 8; ++i) { const int dk = dk0 + i, j = dk & 127; const f32x2 cs = rope[(size_t)m * 128 + j];
                const float k1 = KV[(size_t)m * 6144 + h * 256 + j], k2 = KV[(size_t)m * 6144 + h * 256 + 128 + j];
                const float kr = (dk < 128) ? (k1 * cs.x - k2 * cs.y) : (k1 * cs.y + k2 * cs.x);
                s[i] += kr * vm; }
        }
        bf16* vs = WSP(bf16, WS_VS) + ((size_t)bh * 8 * 512 + dv) * 512 + 256 + dk0;
        for (int sc = 0; sc < 8; ++sc) {
            u32x4* p = (u32x4*)(vs + (size_t)sc * 512 * 512); const u32x4 c = *p;
            u32x4 o; o.x = pk2(s[0], s[1]); o.y = pk2(s[2], s[3]); o.z = pk2(s[4], s[5]); o.w = pk2(s[6], s[7]); *p = o;
            s[0] = g256 * (s[0] + bflo(c.x)); s[1] = g256 * (s[1] + bfhi(c.x)); s[2] = g256 * (s[2] + bflo(c.y)); s[3] = g256 * (s[3] + bfhi(c.y));
            s[4] = g256 * (s[4] + bflo(c.z)); s[5] = g256 * (s[5] + bfhi(c.z)); s[6] = g256 * (s[6] + bflo(c.w)); s[7] = g256 * (s[7] + bfhi(c.w));
        }
    }
}
DI void ret_norm_phase(Frame& F) {
    const int gw = F.bid * NWAVES + F.wave, NGW = F.G * NWAVES, lane = F.lane;
    const bf16* O = WSP(bf16, WS_O1); const bf16* GT = WSP(bf16, WS_GATE1); bf16* MX = WSP(bf16, WS_MIXED1);
    for (int row = gw; row < TM; row += NGW) {
#pragma unroll 2
        for (int h = 0; h < 8; ++h) {
            const size_t off = (size_t)row * 4096 + h * 512 + 8 * lane;
            const u32x4 o = *(const u32x4*)(O + off), g = *(const u32x4*)(GT + off);
            float v[8] = {bflo(o.x), bfhi(o.x), bflo(o.y), bfhi(o.y), bflo(o.z), bfhi(o.z), bflo(o.w), bfhi(o.w)};
            const float gv[8] = {bflo(g.x), bfhi(g.x), bflo(g.y), bfhi(g.y), bflo(g.z), bfhi(g.z), bflo(g.w), bfhi(g.w)};
            float s = 0.f;
#pragma unroll
            for (int i = 0; i < 8; ++i) s += v[i];
            const float mean = wave_sum(s) * (1.f / 512.f); float s2 = 0.f;
#pragma unroll
            for (int i = 0; i < 8; ++i) { v[i] -= mean; s2 += v[i] * v[i]; }
            const float rstd = 1.f / sqrtf(wave_sum(s2) * (1.f / 512.f) + LN_EPS);
            const f32x4 g0 = *(const f32x4*)(F.inp(I_RNG) + h * 512 + 8 * lane), g1 = *(const f32x4*)(F.inp(I_RNG) + h * 512 + 8 * lane + 4);
            u32x4 w; w.x = pk2(v[0] * rstd * g0[0] * gv[0], v[1] * rstd * g0[1] * gv[1]); w.y = pk2(v[2] * rstd * g0[2] * gv[2], v[3] * rstd * g0[3] * gv[3]);
            w.z = pk2(v[4] * rstd * g1[0] * gv[4], v[5] * rstd * g1[1] * gv[5]); w.w = pk2(v[6] * rstd * g1[2] * gv[6], v[7] * rstd * g1[3] * gv[7]);
            *(u32x4*)(MX + off) = w;
        }
    }
}
struct Args { const float* in[31]; float* out; unsigned char* ws; int ph_lo, ph_hi, li, pad; };
constexpr int NPHASE = 21;

__global__ void __launch_bounds__(NTHR, 2) mk_fwd(Args args) {
    extern __shared__ __attribute__((aligned(16))) unsigned char lds_raw[];
    Frame F;
    F.lds = (LAS unsigned char*)lds_raw;
    F.tid = threadIdx.x; F.lane = F.tid & 63; F.wave = __builtin_amdgcn_readfirstlane(F.tid >> 6);
    F.G = gridDim.x; F.bid = blockIdx.x; F.ws = args.ws; F.out = args.out;
    volatile LAS unsigned* MISC = (volatile LAS unsigned*)(F.lds + MISC_OFF);
    volatile LAS int* TP = (volatile LAS int*)(F.lds + MISC_OFF + 256);
    volatile LAS int* CN = (volatile LAS int*)(F.lds + MISC_OFF + 1024);
    for (int u = F.tid; u < (LDS_BYTES - MISC_OFF) / 4; u += NTHR) MISC[u] = 0u;
    __syncthreads();
    if (F.tid < 31) { const unsigned long long p = (unsigned long long)args.in[F.tid]; MISC[512 + 2 * F.tid] = (unsigned)p; MISC[512 + 2 * F.tid + 1] = (unsigned)(p >> 32); }
    __syncthreads();
    XcdBarrier bar = xcd_barrier_post(WSP(unsigned, WS_CTL) + CW_BAR + args.li * XCD_BAR_WORDS, MISC + 8);
    const int lo = args.ph_lo, hi = args.ph_hi;
#ifndef PHMASK
#define PHMASK 0x1fffff
#endif
#define IN(k) (((PHMASK >> (k)) & 1) && lo <= (k) && (k) < hi)
#define SEAM(k) do { if (IN(k) && IN((k) + 1)) xcd_barrier(bar); } while (0)
    LAS unsigned char* ring = F.lds;
    const int G = F.G, bid = F.bid;

    if (IN(0)) { p0_prologue(F); }
    SEAM(0);
    if (IN(1)) {
        p1_skinny(F);
        __syncthreads();
        { DenseSched S; S.init(WSP(bf16, WS_XB), 4096, WSP(bf16, WS_WIN0T), 4096, 2048, 32, 8, 0, 4, 12, G, bid);
          EpiIn0 E{WSP(bf16, WS_U), WSP(bf16, WS_QRAW), WSP(bf16, WS_KRAW), WSP(bf16, WS_R)};
          pg8::gemm_phase<EpiIn0, DenseSched, false>(ring, S, E); }
        { DenseSched S; S.init(WSP(bf16, WS_XB), 4096, WSP(bf16, WS_WIN0T), 4096, 2048, 32, 4, 8, 0, 0, G, (bid + G / 2) % G);
          EpiVT0 E{WSP(bf16, WS_VT0)};
          pg8::gemm_phase<EpiVT0, DenseSched, true>(ring, S, E); }
    }
    SEAM(1);
    if (IN(2)) {
        for (int u = bid; u < 256; u += G) s5_unit(F, u >> 6, u & 63);
        for (int u = bid; u < 516; u += G) { if (u < 512) gla_pre_unit(F, u >> 7, (u >> 2) & 31, u & 3); else gla_meta_unit(F, u - 512); }
    }
    SEAM(2);
    if (IN(3)) { gla_scan(F); }
    SEAM(3);
    if (IN(4)) {
        glu_meta_skinny(F);
        if (G == 256) {
            if (bid >= 128) { for (int k = 0; k < 3; ++k) { const int u = (bid - 128) + 128 * k; gla_out_unit(F, u >> 7, (u >> 2) & 31, u & 3); } }
            else { const int u = 384 + bid; gla_out_unit(F, u >> 7, (u >> 2) & 31, u & 3); }
        } else { for (int u = bid; u < 512; u += G) gla_out_unit(F, u >> 7, (u >> 2) & 31, u & 3); }
        __syncthreads();
        { DenseSched S; S.init(WSP(bf16, WS_Z), 2048, WSP(bf16, WS_WGLUT), 2048, 1024, 32, 4, 0, 0, 0, G, bid);
          EpiGlu E{WSP(bf16, WS_Z), WSP(bf16, WS_MIXED0)};
          pg8::gemm_phase<EpiGlu, DenseSched, false>(ring, S, E); }
    }
    SEAM(4);
    if (IN(5)) {
        out0_meta_skinny(F);
        __syncthreads();
        DenseSched S; S.init(WSP(bf16, WS_MIXED0), 4096, WSP(bf16, WS_WOUT0T), 4096, 2048, 32, 8, 0, 0, 0, G, bid);
        EpiOut E{F.inp(I_X), WSP(float, WS_Y0)};
        pg8::gemm_phase<EpiOut, DenseSched, false>(ring, S, E);
    }
    SEAM(5);
    if (IN(6)) { ln_router_phase(F, 0, TR); }
    SEAM(6);
    if (IN(7)) {
        moe_tables(F, 0, TR, TP, CN);
        MoeSchedGU S; S.lda = 4096; S.ldb = 4096; S.K = 2048; S.TP = TP; S.CNT = CN; S.A = (const char*)WSP(bf16, WS_H1B); S.B = (const char*)WSP(bf16, WS_WGU);
        S.rowidx = WSP(int, WS_ROWIDX); S.nct = 4; S.ntiles = TP[NEX]; S.G = G; S.c = bid; S.down = 0; S.bstride = (size_t)1024 * 2048 * 2;
        EpiMoeGU E{WSP(bf16, WS_HBUF)};
        pg8::gemm_phase<EpiMoeGU, MoeSchedGU, false>(ring, S, E);
    }
    SEAM(7);
    if (IN(8)) {
        moe_tables(F, 0, TR, TP, CN);
        MoeSchedDN S; S.lda = 1024; S.ldb = 1024; S.K = 512; S.TP = TP; S.CNT = CN; S.A = (const char*)WSP(bf16, WS_HBUF); S.B = (const char*)WSP(bf16, WS_WD);
        S.rowidx = nullptr; S.nct = 8; S.ntiles = TP[NEX]; S.G = G; S.c = bid; S.down = 1; S.bstride = (size_t)2048 * 512 * 2;
        EpiMoeDN E{WSP(bf16, WS_YBUF)};
        pg8::gemm_phase<EpiMoeDN, MoeSchedDN, false>(ring, S, E);
    }
    SEAM(8);
    if (IN(9)) { moe_tables(F, 0, TR, TP, CN); combine_ln_phase(F, 0, TR, TP); }
    SEAM(9);
    if (IN(10)) {
        kv1_meta_skinny(F);
        __syncthreads();
        { DenseSched S; S.init(WSP(bf16, WS_H2B), 4096, WSP(bf16, WS_WIN1T), 4096, 2048, 32, 16, 0, 16, 32, G, bid);
          EpiIn1 E{WSP(bf16, WS_PQ), WSP(bf16, WS_KN1), WSP(bf16, WS_GATE1), WSP(f32x2, WS_ROPE)};
          pg8::gemm_phase<EpiIn1, DenseSched, false>(ring, S, E); }
        { DenseSched S; S.init(WSP(bf16, WS_H2B), 4096, WSP(bf16, WS_WIN1T), 4096, 2048, 32, 24, 8, 0, 0, G, bid);
          EpiIn1T E{WSP(bf16, WS_KNT1), WSP(bf16, WS_VS), WSP(f32x2, WS_ROPE)};
          pg8::gemm_phase<EpiIn1T, DenseSched, true>(ring, S, E); }
    }
    SEAM(10);
    if (IN(11)) {
        BatchSched S; S.lda = 1024; S.ldb = 4096; S.K = 256; S.A = (const char*)WSP(bf16, WS_VS); S.B = (const char*)WSP(bf16, WS_KNT1);
        S.sA_g = (size_t)512 * 512 * 2; S.sA_j = (size_t)256 * 512 * 2; S.sB_b = (size_t)2048 * 2048 * 2; S.sB_h = (size_t)256 * 2048 * 2; S.sB_sc = 512; S.sB_g = 0; S.sB_j = 0;
        S.per = 2; S.n = 512; S.G = G; S.c = bid;
        EpiRetA E{WSP(bf16, WS_VS)};
        pg8::gemm_phase<EpiRetA, BatchSched, false>(ring, S, E);
    }
    SEAM(11);
    if (IN(12)) { ret_scan(F); }
    SEAM(12);
    if (IN(13)) {
        BatchSched S; S.lda = 1024; S.ldb = 4096; S.K = 256; S.A = (const char*)(WSP(bf16, WS_PQ) + 256); S.B = (const char*)WSP(bf16, WS_KN1);
        S.sA_g = (size_t)256 * 512 * 2; S.sA_j = 0; S.sB_b = (size_t)2048 * 2048 * 2; S.sB_h = 512; S.sB_sc = (size_t)256 * 2048 * 2; S.sB_g = 0; S.sB_j = 0;
        S.per = 1; S.n = 256; S.G = G; S.c = bid;
        EpiRetP E{WSP(bf16, WS_PQ)};
        pg8::gemm_phase<EpiRetP, BatchSched, false>(ring, S, E);
    }
    SEAM(13);
    if (IN(14)) {
        BatchSched S; S.lda = 1024; S.ldb = 1024; S.K = 512; S.A = (const char*)WSP(bf16, WS_PQ); S.B = (const char*)WSP(bf16, WS_VS);
        S.sA_g = (size_t)256 * 512 * 2; S.sA_j = 0; S.sB_b = 0; S.sB_h = 0; S.sB_sc = 0; S.sB_g = (size_t)512 * 512 * 2; S.sB_j = (size_t)256 * 512 * 2;
        S.per = 2; S.n = 512; S.G = G; S.c = bid;
        EpiRetO E{WSP(bf16, WS_O1)};
        pg8::gemm_phase<EpiRetO, BatchSched, false>(ring, S, E);
    }
    SEAM(14);
    if (IN(15)) { ret_norm_phase(F); }
    SEAM(15);
    if (IN(16)) {
        DenseSched S; S.init(WSP(bf16, WS_MIXED1), 8192, WSP(bf16, WS_WOUT1T), 8192, 4096, 32, 8, 0, 0, 0, G, bid);
        EpiOut E{WSP(float, WS_H2F), WSP(float, WS_Y0)};
        pg8::gemm_phase<EpiOut, DenseSched, false>(ring, S, E);
    }
    SEAM(16);
    if (IN(17)) { ln_router_phase(F, 1, TM); }
    SEAM(17);
    if (IN(18)) {
        moe_tables(F, 1, TM, TP, CN);
        MoeSchedGU S; S.lda = 4096; S.ldb = 4096; S.K = 2048; S.TP = TP; S.CNT = CN; S.A = (const char*)WSP(bf16, WS_H1B); S.B = (const char*)(WSP(bf16, WS_WGU) + (size_t)NEX * 1024 * 2048);
        S.rowidx = WSP(int, WS_ROWIDX); S.nct = 4; S.ntiles = TP[NEX]; S.G = G; S.c = bid; S.down = 0; S.bstride = (size_t)1024 * 2048 * 2;
        EpiMoeGU E{WSP(bf16, WS_HBUF)};
        pg8::gemm_phase<EpiMoeGU, MoeSchedGU, false>(ring, S, E);
    }
    SEAM(18);
    if (IN(19)) {
        moe_tables(F, 1, TM, TP, CN);
        MoeSchedDN S; S.lda = 1024; S.ldb = 1024; S.K = 512; S.TP = TP; S.CNT = CN; S.A = (const char*)WSP(bf16, WS_HBUF); S.B = (const char*)(WSP(bf16, WS_WD) + (size_t)NEX * 2048 * 512);
        S.rowidx = nullptr; S.nct = 8; S.ntiles = TP[NEX]; S.G = G; S.c = bid; S.down = 1; S.bstride = (size_t)2048 * 512 * 2;
        EpiMoeDN E{WSP(bf16, WS_YBUF)};
        pg8::gemm_phase<EpiMoeDN, MoeSchedDN, false>(ring, S, E);
    }
    SEAM(19);
    if (IN(20)) { moe_tables(F, 1, TM, TP, CN); combine_ln_phase(F, 1, TM, TP); }
#undef IN
#undef SEAM
}

#ifndef MK_CUTS
#define MK_CUTS 0
#endif
extern "C" void kernel_launch(void* const* d_in, const int* in_sizes, int n_in, void* d_out, int out_size, void* d_ws, size_t ws_size, hipStream_t stream) {
    static int grid = 0;
    if (grid == 0) {
        if (n_in != 31 || ws_size < WS_END) { fprintf(stderr, "kernel_launch: expected 31 inputs and >= %zu bytes of workspace (got %d, %zu)\n", (size_t)WS_END, n_in, ws_size); grid = -1; return; }
        int dev = 0, cus = 0, per_cu = 0;
        if (hipGetDevice(&dev) != hipSuccess || hipDeviceGetAttribute(&cus, hipDeviceAttributeMultiprocessorCount, dev) != hipSuccess) { grid = -1; return; }
        if (hipFuncSetAttribute((const void*)mk_fwd, hipFuncAttributeMaxDynamicSharedMemorySize, LDS_BYTES) != hipSuccess) { fprintf(stderr, "kernel_launch: hipFuncSetAttribute failed\n"); grid = -1; return; }
        if (hipOccupancyMaxActiveBlocksPerMultiprocessor(&per_cu, (const void*)mk_fwd, NTHR, LDS_BYTES) != hipSuccess || per_cu < 1) { fprintf(stderr, "kernel_launch: occupancy query says %d\n", per_cu); }
        (void)hipGetLastError();
        grid = cus;
    }
    if (grid < 0) return;
    (void)hipMemsetAsync((char*)d_ws + WS_CTL, 0, CTL_ZERO_BYTES, stream);
    Args a{};
    for (int i = 0; i < 31; ++i) a.in[i] = (const float*)d_in[i];
    a.out = (float*)d_out; a.ws = (unsigned char*)d_ws; a.pad = 0;
#if MK_CUTS == 0
    a.ph_lo = 0; a.ph_hi = NPHASE; a.li = 0;
    hipLaunchKernelGGL(mk_fwd, dim3(grid), dim3(NTHR), LDS_BYTES, stream, a);
#else
    for (int p = 0; p < NPHASE; ++p) { a.ph_lo = p; a.ph_hi = p + 1; a.li = 0; hipLaunchKernelGGL(mk_fwd, dim3(grid), dim3(NTHR), LDS_BYTES, stream, a); }
#endif
}
```

```cpp
#include <hip/hip_runtime.h>
#include <cstdio>
#include <cstdint>

#define DI __device__ __forceinline__
#define LAS __attribute__((address_space(3)))
#define GAS __attribute__((address_space(1)))
typedef unsigned short bf16;
typedef short bf16x8 __attribute__((ext_vector_type(8)));
typedef short s16x4 __attribute__((ext_vector_type(4)));
typedef float f32x4 __attribute__((ext_vector_type(4)));
typedef float f32x2 __attribute__((ext_vector_type(2)));
typedef unsigned u32x4 __attribute__((ext_vector_type(4)));
typedef unsigned u32x2 __attribute__((ext_vector_type(2)));
typedef __bf16 bf2_t __attribute__((ext_vector_type(2)));
typedef GAS unsigned gu32;
#define RLX_AGENT __ATOMIC_RELAXED, __HIP_MEMORY_SCOPE_AGENT
#define MFMA16(a, b, c) __builtin_amdgcn_mfma_f32_16x16x32_bf16((a), (b), (c), 0, 0, 0)

DI unsigned pk2(float lo, float hi) { bf2_t v; v.x = (__bf16)lo; v.y = (__bf16)hi; return __builtin_bit_cast(unsigned, v); }
DI bf16 f2bf(float f) { return (bf16)(pk2(f, 0.f) & 0xffffu); }
DI float bf2f(unsigned b) { return __uint_as_float(b << 16); }
DI float bflo(unsigned w) { return __uint_as_float(w << 16); }
DI float bfhi(unsigned w) { return __uint_as_float(w & 0xffff0000u); }
DI u32x4 pk8(f32x4 a, f32x4 b) { u32x4 w; w.x = pk2(a[0], a[1]); w.y = pk2(a[2], a[3]); w.z = pk2(b[0], b[1]); w.w = pk2(b[2], b[3]); return w; }
DI float sigmoidf_(float x) { return 1.0f / (1.0f + __expf(-x)); }
DI float siluf_(float x) { return x / (1.0f + __expf(-x)); }
DI float gelu_tanh(float x) { const float u = 0.7978845608028654f * (x + 0.044715f * x * x * x); const float e = __expf(-2.0f * fabsf(u)); const float t = (1.0f - e) / (1.0f + e); return 0.5f * x * (1.0f + (u < 0.f ? -t : t)); }
DI float wave_sum(float v) {
#pragma unroll
    for (int o = 1; o < 64; o <<= 1) v += __shfl_xor(v, o);
    return v;
}

constexpr int D = 2048, NB = 4, SEQ = 2048, TM = 8192, NMETA = 16, TR = TM + NMETA, TRP = 8448;
constexpr int S5W = 1024, GQK = 512, GWD = 1024, ABC = 4112, GDK = 128, GDV = 256;
constexpr int RQK = 2048, RWD = 4096, RETC = 12288, RDK = 256, RDV = 512, RH = 8;
constexpr int NE = 64, NEX = 65, FF = 512, TOPK = 8;
constexpr float ALPHA = 1.4142135623730951f;
constexpr float LN_EPS = 1e-5f;
constexpr int NWAVES = 8, NTHR = 512;

constexpr size_t MiB = 1u << 20;
constexpr size_t WS_CTL = 0, CTL_ZERO_BYTES = 4 * MiB;
constexpr size_t WS_WIN0T = 4 * MiB;
constexpr size_t WS_WGLUT = 21 * MiB;
constexpr size_t WS_WOUT0T = 23 * MiB;
constexpr size_t WS_WIN1T = 31 * MiB;
constexpr size_t WS_WOUT1T = 79 * MiB;
constexpr size_t WS_RT = 95 * MiB;
constexpr size_t WS_TM = 96 * MiB;
constexpr size_t WS_BKT = 108 * MiB;
constexpr size_t WS_A16 = 112 * MiB;
constexpr size_t WS_ROPE = 113 * MiB;
constexpr size_t WS_WGU = 116 * MiB;
constexpr size_t WS_WD = 636 * MiB;
constexpr size_t WS_XB = 896 * MiB;
constexpr size_t WS_U = 929 * MiB;
constexpr size_t WS_UMETA = 945 * MiB;
constexpr size_t WS_QRAW = 946 * MiB;
constexpr size_t WS_KRAW = 955 * MiB;
constexpr size_t WS_R = 964 * MiB;
constexpr size_t WS_VT0 = 981 * MiB;
constexpr size_t WS_Z = 997 * MiB;
constexpr size_t WS_MIXED0 = 1014 * MiB;
constexpr size_t WS_QS = 1047 * MiB;
constexpr size_t WS_KN = 1056 * MiB;
constexpr size_t WS_ST0 = 1065 * MiB;
constexpr size_t WS_GL = 1097 * MiB;
constexpr size_t WS_PMETA = 1098 * MiB;
constexpr size_t WS_DC0 = 1099 * MiB;
constexpr size_t WS_SMETA0 = 1100 * MiB;
constexpr size_t WS_KVMETA = 1101 * MiB;
constexpr size_t WS_ROUTE = 1102 * MiB;
constexpr size_t WS_ROWIDX = 1103 * MiB;
constexpr size_t WS_Y0 = 1106 * MiB;
constexpr size_t WS_H1F = 1172 * MiB;
constexpr size_t WS_H1B = 1238 * MiB;
constexpr size_t WS_H2F = 1271 * MiB;
constexpr size_t WS_H2B = 1337 * MiB;
constexpr size_t WS_HBUF = 1370 * MiB;
constexpr size_t WS_YBUF = 1459 * MiB;
constexpr size_t WS_END = 1812 * MiB;
constexpr size_t WS_PQ = WS_YBUF;
constexpr size_t WS_KN1 = WS_YBUF + 64 * MiB;
constexpr size_t WS_KNT1 = WS_YBUF + 97 * MiB;
constexpr size_t WS_VS = WS_YBUF + 129 * MiB;
constexpr size_t WS_GATE1 = WS_YBUF + 257 * MiB;
constexpr size_t WS_O1 = WS_XB;
constexpr size_t WS_MIXED1 = WS_VT0;
static_assert(WS_O1 + 64 * MiB <= WS_VT0 && WS_MIXED1 + 64 * MiB <= WS_QS, "layer-1 aliases");
static_assert(WS_GATE1 + 66 * MiB <= WS_END, "gate1");
constexpr int MAXSLOTS = 90368;
constexpr int CW_BAR = 4096;
constexpr int CW_CNT = 65536;
constexpr int XCD_BAR_WORDS_C = 3456;
constexpr int MAX_LAUNCH = 16;
static_assert(CW_BAR + MAX_LAUNCH * XCD_BAR_WORDS_C <= CW_CNT, "ctl map");

constexpr int RING_BYTES = 131072;
constexpr int MISC_OFF = RING_BYTES;
constexpr int LDS_BYTES = 147456;

#define XB_TMO      128
#define XB_XCNT(j)  (256  + 64 * (j))
#define XB_XSUB(j)  (1280 + 64 * (j))
#define XB_XGEN(j)  (2304 + 64 * (j))
#define XB_TOP      3328
#define XB_TOPGEN   3392
#define XCD_BAR_WORDS 3456
#define XB_SPIN_CAP (1u << 18)
DI unsigned xb_ld(unsigned* p)              { return __hip_atomic_load(p, __ATOMIC_RELAXED, __HIP_MEMORY_SCOPE_AGENT); }
DI unsigned xb_add(unsigned* p, unsigned v) { return __hip_atomic_fetch_add(p, v, __ATOMIC_RELAXED, __HIP_MEMORY_SCOPE_AGENT); }
DI unsigned xb_xcc_id() { return (unsigned)__builtin_amdgcn_s_getreg((3 << 11) | 20) & 0xFu; }
#define XB_SPIN(cond, bar) do { unsigned _sp = 0; while (cond) { __builtin_amdgcn_s_sleep(1); \
    if ((++_sp & 255u) == 0u) { if (xb_ld(&(bar)[XB_TMO])) break; if (_sp > XB_SPIN_CAP) { atomicAdd(&(bar)[XB_TMO], 1u); break; } } } } while (0)
struct XcdBarrier { unsigned* bar; unsigned x; volatile LAS unsigned* st; };
DI XcdBarrier xcd_barrier_post(unsigned* bar, volatile LAS unsigned* st) {
    XcdBarrier b; b.bar = bar; b.x = xb_xcc_id(); b.st = st;
    if (threadIdx.x == 0) (void)xb_add(&bar[XB_XCNT(b.x)], 1u);
    return b;
}
DI void xcd_barrier_complete(unsigned* bar, unsigned x, unsigned& nloc, unsigned& nx) {
    const unsigned G = gridDim.x * gridDim.y * gridDim.z;
    unsigned sum, cnt, mine, sp = 0u;
    for (;;) {
        sum = 0u; cnt = 0u; mine = 0u;
#pragma unroll
        for (unsigned j = 0; j < 16; ++j) { const unsigned c = xb_ld(&bar[XB_XCNT(j)]); sum += c; cnt += (c > 0u) ? 1u : 0u; mine = (j == x) ? c : mine; }
        if (sum == G) break;
        __builtin_amdgcn_s_sleep(1);
        if ((++sp & 255u) == 0u) { if (xb_ld(&bar[XB_TMO])) break; if (sp > XB_SPIN_CAP) { atomicAdd(&bar[XB_TMO], 1u); break; } }
    }
    nloc = mine > 0u ? mine : 1u; nx = cnt > 0u ? cnt : 1u;
}
DI void xcd_barrier(const XcdBarrier& b) {
    asm volatile("s_waitcnt vmcnt(0)" ::: "memory");
    __syncthreads();
    if (threadIdx.x == 0) {
        unsigned* bar = b.bar;
        __builtin_amdgcn_s_waitcnt(0);
        unsigned nloc = b.st[0], nx = b.st[1];
        if (nloc == 0u) { xcd_barrier_complete(bar, b.x, nloc, nx); b.st[0] = nloc; b.st[1] = nx; }
        const unsigned old = xb_add(&bar[XB_XSUB(b.x)], 1u);
        const unsigned gen = old / nloc;
        if (old + 1u == (gen + 1u) * nloc) {
            __builtin_amdgcn_fence(__ATOMIC_RELEASE, "agent");
            asm volatile("s_waitcnt vmcnt(0)" ::: "memory");
            const unsigned og = xb_add(&bar[XB_TOP], 1u);
            const unsigned tg = og / nx;
            if (og + 1u == (tg + 1u) * nx) xb_add(&bar[XB_TOPGEN], 1u);
            else XB_SPIN(xb_ld(&bar[XB_TOPGEN]) == tg, bar);
            __builtin_amdgcn_fence(__ATOMIC_ACQUIRE, "agent");
            xb_add(&bar[XB_XGEN(b.x)], 1u);
            asm volatile("s_waitcnt vmcnt(0)" ::: "memory");
        } else {
            XB_SPIN(xb_ld(&bar[XB_XGEN(b.x)]) == gen, bar);
            __builtin_amdgcn_fence(__ATOMIC_ACQUIRE, "agent");
            asm volatile("s_waitcnt vmcnt(0)" ::: "memory");
        }
    }
    __syncthreads();
}
namespace pg8 {
constexpr int BM = 256, BK = 64, HALF = 128, HTB = HALF * BK * 2, STAGE_BYTES = 8 * HTB;
DI int lds_byte(int r, int c) { const int st = (r >> 4) * 2 + (c >> 5), rr = r & 15, cc = c & 31, ob = rr * 64 + cc * 2; return st * 1024 + (ob ^ (((ob >> 9) & 1) << 5)); }
DI void stage_rc(int b, int& R, int& C) { const int st = b / 1024, sb = b % 1024, swz = sb ^ (((sb >> 9) & 1) << 5); R = (st >> 1) * 16 + swz / 64; C = (st & 1) * 32 + (swz % 64) / 2; }
DI int perm32(int rho) { const int n = rho >> 4, i = rho & 15; return 8 * (i >> 2) + 4 * n + (i & 3); }
DI int permrow(int R) { return (R & ~31) + perm32(R & 31); }

struct GUnit { const char* A; const char* B; const int* rows; int r0, c0, aux, nvalid; };

template <class Epi, class Sched, bool TRANS>
DI void gemm_phase(LAS unsigned char* lds, const Sched& S, const Epi& E) {
    const int tid = threadIdx.x, wid = __builtin_amdgcn_readfirstlane(tid >> 6), lane = tid & 63, wr = wid >> 2, wc = wid & 3, fr = lane & 15, fq = lane >> 4;
    const int K = S.K, nt = K / BK;
    const unsigned lda = (unsigned)S.lda, ldb = (unsigned)S.ldb;
    const int R0 = (wid >> 1) * 16 + (lane >> 2), C0 = (wid & 1) * 32 + ((((lane * 16) & 63) ^ (((lane >> 5) & 1) << 5)) >> 1);
    const unsigned voffB0 = (unsigned)(TRANS ? R0 : permrow(R0)) * ldb + (unsigned)C0 * 2u;
    const unsigned voffA0 = (unsigned)(TRANS ? permrow(R0) : R0) * lda + (unsigned)C0 * 2u;
    LAS int* gtab = (LAS int*)(lds + 131072 + 8192);
    const size_t kstep = (size_t)(BK * 2);
    const unsigned ldsw = (unsigned)wid * 1024u;
    const int aoff = lds_byte(wr * 64 + fr, fq * 8), boff = lds_byte(wc * 32 + fr, fq * 8);
#define PG8_SA(b, h) (((b) * 2 + (h)) * HTB)
#define PG8_SB(b, h) ((4 + (b) * 2 + (h)) * HTB)
#define PG8_GLDS(gptr, bufoff, _i) __builtin_amdgcn_global_load_lds((const unsigned*)(gptr), (LAS unsigned*)(lds + (bufoff) + ldsw + (_i) * 8192), 16, 0, 0)
#define PG8_STAGE_B(bufoff, gbase, h) do { _Pragma("unroll") for (int _i = 0; _i < 2; ++_i) PG8_GLDS((const char*)(gbase) + (size_t)((h) * HALF + _i * 64) * ldb + voffB0, bufoff, _i); } while (0)
#define PG8_STAGE_A(bufoff, gbase, h, tb, nv) do { _Pragma("unroll") for (int _i = 0; _i < 2; ++_i) { \
        if constexpr (Sched::GATHER) { const int _r = (h) * HALF + _i * 64 + R0; const int _ix = gtab[(tb) * 256 + (_r < (nv) ? _r : 0)]; \
            PG8_GLDS((const char*)(gbase) + ((unsigned)_ix * lda + (unsigned)C0 * 2u), bufoff, _i); } \
        else PG8_GLDS((const char*)(gbase) + (size_t)((h) * HALF + _i * 64) * lda + voffA0, bufoff, _i); } } while (0)
#define PG8_LDA(dst, b, h) do { _Pragma("unroll") for (int m = 0; m < 4; ++m) _Pragma("unroll") for (int k = 0; k < 2; ++k) dst[m][k] = *(const LAS bf16x8*)(lds + PG8_SA(b, h) + aoff + m * 2048 + k * 1024); } while (0)
#define PG8_LDB(dst, b, h) do { _Pragma("unroll") for (int n = 0; n < 2; ++n) _Pragma("unroll") for (int k = 0; k < 2; ++k) dst[n][k] = *(const LAS bf16x8*)(lds + PG8_SB(b, h) + boff + n * 2048 + k * 1024); } while (0)
#define PG8_MMA(ai, bj, At, Bt) do { __builtin_amdgcn_s_setprio(1); _Pragma("unroll") for (int m = 0; m < 4; ++m) _Pragma("unroll") for (int n = 0; n < 2; ++n) _Pragma("unroll") for (int k = 0; k < 2; ++k) \
        acc[ai][bj][m][n] = TRANS ? __builtin_amdgcn_mfma_f32_16x16x32_bf16(At[m][k], Bt[n][k], acc[ai][bj][m][n], 0, 0, 0) \
                                  : __builtin_amdgcn_mfma_f32_16x16x32_bf16(Bt[n][k], At[m][k], acc[ai][bj][m][n], 0, 0, 0); __builtin_amdgcn_s_setprio(0); } while (0)
#define PG8_WAIT_V(n) asm volatile("s_waitcnt vmcnt(" #n ")" ::: "memory")
#define PG8_WAIT_L(n) asm volatile("s_waitcnt lgkmcnt(" #n ")" ::: "memory")
#define PG8_BAR __builtin_amdgcn_s_barrier()
#define PG8_SCHED __builtin_amdgcn_sched_barrier(0)
    GUnit cur, nxt; int ui = 0;
    if (!S.next(0, cur)) return;
    if constexpr (Sched::GATHER) { if (tid < 256) gtab[tid] = cur.rows[tid < cur.nvalid ? tid : 0]; asm volatile("s_waitcnt vmcnt(0) lgkmcnt(0)" ::: "memory"); PG8_BAR; }
    f32x4 acc[2][2][4][2];
#pragma unroll
    for (int a = 0; a < 2; ++a)
#pragma unroll
        for (int b = 0; b < 2; ++b)
#pragma unroll
            for (int m = 0; m < 4; ++m)
#pragma unroll
                for (int n = 0; n < 2; ++n) acc[a][b][m][n] = (f32x4){0.f, 0.f, 0.f, 0.f};
    bf16x8 At[4][2], B0[2][2], B1[2][2];
    const char* cA = cur.A; const char* cB = cur.B;
    PG8_STAGE_B(PG8_SB(0, 0), cB, 0); PG8_STAGE_B(PG8_SB(0, 1), cB, 1); PG8_STAGE_A(PG8_SA(0, 0), cA, 0, 0, cur.nvalid); PG8_STAGE_A(PG8_SA(0, 1), cA, 1, 0, cur.nvalid);
    if (wr == 1) PG8_BAR;
    PG8_WAIT_V(2); PG8_BAR;
    PG8_STAGE_B(PG8_SB(1, 0), cB + kstep, 0); PG8_STAGE_A(PG8_SA(1, 0), cA + kstep, 0, 0, cur.nvalid); PG8_STAGE_B(PG8_SB(1, 1), cB + kstep, 1);
    PG8_WAIT_V(6); PG8_BAR;
    for (;;) {
        const bool has_next = S.next(ui + 1, nxt);
        const int tb = ui & 1, ntb = has_next ? (tb ^ 1) : tb, cnv = cur.nvalid, nnv = has_next ? nxt.nvalid : cur.nvalid;
        if constexpr (Sched::GATHER) {
            if (has_next && tid < 256) __builtin_amdgcn_global_load_lds((const unsigned*)(nxt.rows + tid), (LAS unsigned*)(gtab + ntb * 256 + wid * 64), 4, 0, 0); }
        const char* nA = has_next ? nxt.A : cA; const char* nB = has_next ? nxt.B : cB;
        for (int t = 0; t < nt; t += 2) {
            const bool last = (t == nt - 2);
            const char* a1 = cA + (size_t)(t + 1) * kstep;
            const char* a2 = last ? nA : cA + (size_t)(t + 2) * kstep; const char* b2 = last ? nB : cB + (size_t)(t + 2) * kstep;
            const char* a3 = a2 + kstep; const char* b3 = b2 + kstep;
            PG8_LDB(B0, 0, 0); PG8_LDB(B1, 0, 1); PG8_SCHED; PG8_LDA(At, 0, 0); PG8_STAGE_A(PG8_SA(1, 1), a1, 1, tb, cnv);
            PG8_WAIT_V(8); PG8_WAIT_L(0); PG8_BAR; PG8_MMA(0, 0, At, B0); PG8_MMA(0, 1, At, B1); PG8_BAR; PG8_SCHED;
            PG8_LDA(At, 0, 1); PG8_STAGE_B(PG8_SB(0, 0), b2, 0); PG8_STAGE_B(PG8_SB(0, 1), b2, 1);
            if (Sched::GATHER && last) { PG8_STAGE_A(PG8_SA(0, 0), a2, 0, ntb, nnv); } else { PG8_STAGE_A(PG8_SA(0, 0), a2, 0, tb, cnv); }
            PG8_WAIT_V(8); PG8_WAIT_L(0); PG8_BAR; PG8_MMA(1, 0, At, B0); PG8_MMA(1, 1, At, B1); PG8_BAR; PG8_SCHED;
            PG8_LDB(B0, 1, 0); PG8_LDB(B1, 1, 1); PG8_SCHED; PG8_LDA(At, 1, 0);
            if (Sched::GATHER && last) { PG8_STAGE_A(PG8_SA(0, 1), a2, 1, ntb, nnv); } else { PG8_STAGE_A(PG8_SA(0, 1), a2, 1, tb, cnv); }
            PG8_WAIT_V(8); PG8_WAIT_L(0); PG8_BAR; PG8_MMA(0, 0, At, B0); PG8_MMA(0, 1, At, B1); PG8_BAR; PG8_SCHED;
            PG8_LDA(At, 1, 1); PG8_STAGE_B(PG8_SB(1, 0), b3, 0); PG8_STAGE_B(PG8_SB(1, 1), b3, 1);
            if (Sched::GATHER && last) { PG8_STAGE_A(PG8_SA(1, 0), a3, 0, ntb, nnv); } else { PG8_STAGE_A(PG8_SA(1, 0), a3, 0, tb, cnv); }
            PG8_WAIT_V(8); PG8_WAIT_L(0); PG8_BAR; PG8_MMA(1, 0, At, B0); PG8_MMA(1, 1, At, B1); PG8_BAR; PG8_SCHED;
        }
        if (wr == 0) PG8_BAR;
        E(acc, cur, wr, wc, fr, fq);
        if (!has_next) break;
#pragma unroll
        for (int a = 0; a < 2; ++a)
#pragma unroll
            for (int b = 0; b < 2; ++b)
#pragma unroll
                for (int m = 0; m < 4; ++m)
#pragma unroll
                    for (int n = 0; n < 2; ++n) acc[a][b][m][n] = (f32x4){0.f, 0.f, 0.f, 0.f};
        cur = nxt; cA = nA; cB = nB; ++ui;
        if (wr == 1) PG8_BAR;
    }
    PG8_WAIT_V(0);
    PG8_BAR;
#undef PG8_SA
#undef PG8_SB
#undef PG8_GLDS
#undef PG8_STAGE_A
#undef PG8_STAGE_B
#undef PG8_LDA
#undef PG8_LDB
#undef PG8_MMA
#undef PG8_WAIT_V
#undef PG8_WAIT_L
#undef PG8_BAR
#undef PG8_SCHED
}
}
using pg8::GUnit;
struct DenseSched {
    static constexpr bool GATHER = false;
    int lda, ldb, K;
    const char* A; const char* B;
    int nM, nN, G, c, nN1, ct0, ct1;
    DI void init(const void* A_, int lda_, const void* B_, int ldb_, int K_, int nM_, int nN1_, int ct0_, int nN2_, int ct1_, int G_, int c_) {
        A = (const char*)A_; B = (const char*)B_; lda = lda_; ldb = ldb_; K = K_; nM = nM_; nN1 = nN1_; ct0 = ct0_; ct1 = ct1_; nN = nN1_ + nN2_; G = G_; c = c_; }
    DI bool next(int i, GUnit& u) const {
        const int nwg = nM * nN; const long L = (long)i * G + c; if (L >= nwg) return false;
        int wgid = (int)L; { const int q = nwg / 8, r = nwg % 8, xcd = wgid % 8, off = wgid / 8; wgid = (xcd < r ? xcd * (q + 1) : r * (q + 1) + (xcd - r) * q) + off; }
        const int nig = 8 * nN, gid = wgid / nig, fm = gid * 8, gsz = (nM - fm) < 8 ? (nM - fm) : 8;
        const int pm = fm + ((wgid % nig) % gsz), pn = (wgid % nig) / gsz;
        const int ct = pn < nN1 ? ct0 + pn : ct1 + (pn - nN1);
        u.A = A + (size_t)pm * 256 * (size_t)lda; u.B = B + (size_t)ct * 256 * (size_t)ldb; u.rows = nullptr; u.r0 = pm * 256; u.c0 = ct * 256; u.aux = 0; u.nvalid = 256; return true;
    }
};
struct BatchSched {
    static constexpr bool GATHER = false;
    int lda, ldb, K;
    const char* A; const char* B;
    size_t sA_g, sA_j, sB_b, sB_h, sB_sc, sB_g, sB_j;
    int per, n, G, c;
    DI bool next(int i, GUnit& u) const {
        const long L = (long)i * G + c; if (L >= n) return false;
        const int g = (int)L / per, j = (int)L % per, b = g >> 6, h = (g >> 3) & 7, sc = g & 7;
        u.A = A + g * sA_g + j * sA_j; u.B = B + b * sB_b + h * sB_h + sc * sB_sc + g * sB_g + j * sB_j; u.rows = nullptr; u.r0 = j * 256; u.c0 = 0; u.aux = g; u.nvalid = 256; return true;
    }
};
template <int NCT, bool DOWN> struct MoeSchedT {
    static constexpr bool GATHER = !DOWN;
    int lda, ldb, K;
    const volatile LAS int* TP; const volatile LAS int* CNT; const volatile LAS int* LST;
    const char* A; const char* B; const int* rowidx;
    int nlist, nloc, rank;
    size_t bstride;
    DI bool next(int i, GUnit& u) const {
        const int pos = i * nloc + rank; if (pos >= nlist * NCT) return false;
        const int ent = __builtin_amdgcn_readfirstlane(LST[pos / NCT]), ct = pos % NCT, e = ent >> 16, rt = ent & 0xffff, j = rt - __builtin_amdgcn_readfirstlane(TP[e]);
        u.r0 = rt * 256; u.aux = ct; u.c0 = ct * 256;
        if (DOWN) { u.A = A + (size_t)rt * 256 * (size_t)lda; u.rows = nullptr; u.nvalid = 256; }
        else { u.A = A; u.rows = rowidx + (size_t)e * TRP + j * 256; const int rem = __builtin_amdgcn_readfirstlane(CNT[e]) - j * 256; u.nvalid = rem < 256 ? rem : 256; }
        u.B = B + (size_t)e * bstride + (size_t)ct * 256 * (size_t)ldb;
        return true;
    }
};
typedef MoeSchedT<4, false> MoeSchedGU;
typedef MoeSchedT<8, true> MoeSchedDN;

#define EPI_ARGS const f32x4 (&acc)[2][2][4][2], const GUnit& u, int wr, int wc, int fr, int fq
struct EpiIn0 {
    bf16 *U, *Q, *Kr, *R;
    DI void operator()(EPI_ARGS) const {
        const int c0 = u.c0;
#pragma unroll
        for (int ai = 0; ai < 2; ++ai)
#pragma unroll
            for (int m = 0; m < 4; ++m) {
                const int r = u.r0 + ai * 128 + wr * 64 + m * 16 + fr;
#pragma unroll
                for (int bj = 0; bj < 2; ++bj) {
                    const int c = c0 + bj * 128 + wc * 32 + fq * 8;
                    f32x4 v0 = acc[ai][bj][m][0], v1 = acc[ai][bj][m][1];
                    if (c0 < 1024) { const int b = r >> 11, s = r & 2047, g = c >> 4, ch = c & 15;
                        *(u32x4*)(U + (((size_t)(b * 64 + g) * 2048 + s) * 16 + ch)) = pk8(v0, v1); }
                    else if (c0 < 1536) { const float sc = 0.08838834764831845f; *(u32x4*)(Q + (size_t)r * 512 + (c - 1024)) = pk8(v0 * sc, v1 * sc); }
                    else if (c0 < 2048) { *(u32x4*)(Kr + (size_t)r * 512 + (c - 1536)) = pk8(v0, v1); }
                    else { f32x4 a, b2;
#pragma unroll
                        for (int i = 0; i < 4; ++i) { a[i] = siluf_(v0[i]); b2[i] = siluf_(v1[i]); }
                        *(u32x4*)(R + (size_t)r * 1024 + (c - 3072)) = pk8(a, b2); }
                }
            }
    }
};
struct EpiVT0 {
    bf16* VT;
    DI void operator()(EPI_ARGS) const {
#pragma unroll
        for (int ai = 0; ai < 2; ++ai)
#pragma unroll
            for (int mp = 0; mp < 2; ++mp) {
                const int r = u.r0 + ai * 128 + wr * 64 + mp * 32 + fq * 8, b = r >> 11, s = r & 2047;
#pragma unroll
                for (int bj = 0; bj < 2; ++bj)
#pragma unroll
                    for (int n = 0; n < 2; ++n) {
                        const int c = u.c0 - 2048 + bj * 128 + wc * 32 + n * 16 + fr;
                        *(u32x4*)(VT + ((size_t)(b * 1024 + c) * 2048 + s)) = pk8(acc[ai][bj][2 * mp][n], acc[ai][bj][2 * mp + 1][n]);
                    }
            }
    }
};
struct EpiGlu {
    const bf16* Z; bf16* MX;
    DI void operator()(EPI_ARGS) const {
#pragma unroll
        for (int ai = 0; ai < 2; ++ai)
#pragma unroll
            for (int m = 0; m < 4; ++m) {
                const int r = u.r0 + ai * 128 + wr * 64 + m * 16 + fr;
#pragma unroll
                for (int bj = 0; bj < 2; ++bj) {
                    const int c = u.c0 + bj * 128 + wc * 32 + fq * 8;
                    const u32x4 z = *(const u32x4*)(Z + (size_t)r * 1024 + c);
                    f32x4 v0 = acc[ai][bj][m][0], v1 = acc[ai][bj][m][1], o0, o1;
                    o0[0] = bflo(z.x) * sigmoidf_(v0[0]); o0[1] = bfhi(z.x) * sigmoidf_(v0[1]); o0[2] = bflo(z.y) * sigmoidf_(v0[2]); o0[3] = bfhi(z.y) * sigmoidf_(v0[3]);
                    o1[0] = bflo(z.z) * sigmoidf_(v1[0]); o1[1] = bfhi(z.z) * sigmoidf_(v1[1]); o1[2] = bflo(z.w) * sigmoidf_(v1[2]); o1[3] = bfhi(z.w) * sigmoidf_(v1[3]);
                    *(u32x4*)(MX + (size_t)r * 2048 + c) = pk8(o0, o1);
                }
            }
    }
};
struct EpiOut {
    const float* resid; float* Y;
    DI void operator()(EPI_ARGS) const {
#pragma unroll
        for (int ai = 0; ai < 2; ++ai)
#pragma unroll
            for (int m = 0; m < 4; ++m) {
                const int r = u.r0 + ai * 128 + wr * 64 + m * 16 + fr;
#pragma unroll
                for (int bj = 0; bj < 2; ++bj) {
                    const size_t o = (size_t)r * 2048 + u.c0 + bj * 128 + wc * 32 + fq * 8;
                    const f32x4 x0 = *(const f32x4*)(resid + o), x1 = *(const f32x4*)(resid + o + 4);
                    *(f32x4*)(Y + o) = acc[ai][bj][m][0] + ALPHA * x0; *(f32x4*)(Y + o + 4) = acc[ai][bj][m][1] + ALPHA * x1;
                }
            }
    }
};
struct EpiMoeGU {
    bf16* H;
    DI void operator()(EPI_ARGS) const {
#pragma unroll
        for (int ai = 0; ai < 2; ++ai)
#pragma unroll
            for (int m = 0; m < 4; ++m) {
                const int r = u.r0 + ai * 128 + wr * 64 + m * 16 + fr;
                f32x4 o0, o1;
#pragma unroll
                for (int i = 0; i < 4; ++i) { o0[i] = siluf_(acc[ai][0][m][0][i]) * acc[ai][1][m][0][i]; o1[i] = siluf_(acc[ai][0][m][1][i]) * acc[ai][1][m][1][i]; }
                *(u32x4*)(H + (size_t)r * 512 + u.aux * 128 + wc * 32 + fq * 8) = pk8(o0, o1);
            }
    }
};
struct EpiMoeDN {
    bf16* Y;
    DI void operator()(EPI_ARGS) const {
#pragma unroll
        for (int ai = 0; ai < 2; ++ai)
#pragma unroll
            for (int m = 0; m < 4; ++m) {
                const int r = u.r0 + ai * 128 + wr * 64 + m * 16 + fr;
#pragma unroll
                for (int bj = 0; bj < 2; ++bj)
                    *(u32x4*)(Y + (size_t)r * 2048 + u.c0 + bj * 128 + wc * 32 + fq * 8) = pk8(acc[ai][bj][m][0], acc[ai][bj][m][1]);
            }
    }
};
DI float lg2gamma(int h) { return __log2f(1.0f - exp2f((float)(-5 - h))); }
struct EpiIn1 {
    bf16 *PQ, *KN, *GT; const f32x2* rope;
    DI void operator()(EPI_ARGS) const {
        const int c0 = u.c0;
        if (c0 >= 8192) {
#pragma unroll
            for (int ai = 0; ai < 2; ++ai)
#pragma unroll
                for (int m = 0; m < 4; ++m) {
                    const int r = u.r0 + ai * 128 + wr * 64 + m * 16 + fr;
#pragma unroll
                    for (int bj = 0; bj < 2; ++bj) { f32x4 a, b2;
#pragma unroll
                        for (int i = 0; i < 4; ++i) { a[i] = siluf_(acc[ai][bj][m][0][i]); b2[i] = siluf_(acc[ai][bj][m][1][i]); }
                        *(u32x4*)(GT + (size_t)r * 4096 + (c0 - 8192) + bj * 128 + wc * 32 + fq * 8) = pk8(a, b2); }
                }
            return;
        }
        const bool isq = c0 < 2048; const int h = (isq ? c0 : c0 - 2048) >> 8; const float l2g = lg2gamma(h);
#pragma unroll
        for (int ai = 0; ai < 2; ++ai)
#pragma unroll
            for (int m = 0; m < 4; ++m) {
                const int r = u.r0 + ai * 128 + wr * 64 + m * 16 + fr, b = r >> 11, s = r & 2047, il = s & 255, sc = s >> 8;
                const int j0 = wc * 32 + fq * 8;
                const f32x4* rp = (const f32x4*)(rope + (size_t)(16 + s) * 128 + j0);
                const float dec = isq ? exp2f((float)(il + 1) * l2g) : 0.0625f * exp2f(-(float)(il + 1) * l2g);
                f32x4 o1a, o1b, o2a, o2b;
#pragma unroll
                for (int n = 0; n < 2; ++n) {
                    const f32x4 cs0 = rp[2 * n], cs1 = rp[2 * n + 1];
                    const f32x4 t1 = acc[ai][0][m][n], t2 = acc[ai][1][m][n]; f32x4 p, q2;
                    p[0] = t1[0] * cs0[0] - t2[0] * cs0[1]; q2[0] = t1[0] * cs0[1] + t2[0] * cs0[0];
                    p[1] = t1[1] * cs0[2] - t2[1] * cs0[3]; q2[1] = t1[1] * cs0[3] + t2[1] * cs0[2];
                    p[2] = t1[2] * cs1[0] - t2[2] * cs1[1]; q2[2] = t1[2] * cs1[1] + t2[2] * cs1[0];
                    p[3] = t1[3] * cs1[2] - t2[3] * cs1[3]; q2[3] = t1[3] * cs1[3] + t2[3] * cs1[2];
                    if (n == 0) { o1a = p * dec; o2a = q2 * dec; } else { o1b = p * dec; o2b = q2 * dec; }
                }
                if (isq) { bf16* d = PQ + ((size_t)((b * 8 + h) * 8 + sc) * 256 + il) * 512 + 256 + j0; *(u32x4*)d = pk8(o1a, o1b); *(u32x4*)(d + 128) = pk8(o2a, o2b); }
                else { bf16* d = KN + (size_t)r * 2048 + h * 256 + j0; *(u32x4*)d = pk8(o1a, o1b); *(u32x4*)(d + 128) = pk8(o2a, o2b); }
            }
    }
};
struct EpiIn1T {
    bf16 *KNT, *VS; const f32x2* rope;
    DI void operator()(EPI_ARGS) const {
        const int c0 = u.c0;
        if (c0 >= 4096) {
#pragma unroll
            for (int ai = 0; ai < 2; ++ai)
#pragma unroll
                for (int mp = 0; mp < 2; ++mp) {
                    const int r = u.r0 + ai * 128 + wr * 64 + mp * 32 + fq * 8, b = r >> 11, s = r & 2047, il = s & 255, sc = s >> 8;
#pragma unroll
                    for (int bj = 0; bj < 2; ++bj)
#pragma unroll
                        for (int n = 0; n < 2; ++n) {
                            const int f = c0 - 4096 + bj * 128 + wc * 32 + n * 16 + fr, h = f >> 9, dv = f & 511;
                            *(u32x4*)(VS + ((size_t)((b * 8 + h) * 8 + sc) * 512 + dv) * 512 + il) = pk8(acc[ai][bj][2 * mp][n], acc[ai][bj][2 * mp + 1][n]);
                        }
                }
            return;
        }
        const int h = (c0 - 2048) >> 8; const float l2g = lg2gamma(h);
#pragma unroll
        for (int ai = 0; ai < 2; ++ai)
#pragma unroll
            for (int mp = 0; mp < 2; ++mp) {
                const int r = u.r0 + ai * 128 + wr * 64 + mp * 32 + fq * 8, b = r >> 11, s = r & 2047, il = s & 255;
#pragma unroll
                for (int n = 0; n < 2; ++n) {
                    const int j = wc * 32 + n * 16 + fr;
                    f32x4 o1a, o1b, o2a, o2b;
#pragma unroll
                    for (int t = 0; t < 8; ++t) {
                        const f32x2 cs = rope[(size_t)(16 + s + t) * 128 + j];
                        const float dec = 0.0625f * exp2f(-(float)(il + t + 1) * l2g);
                        const float t1 = acc[ai][0][2 * mp + (t >> 2)][n][t & 3], t2 = acc[ai][1][2 * mp + (t >> 2)][n][t & 3];
                        const float p = (t1 * cs.x - t2 * cs.y) * dec, q2 = (t1 * cs.y + t2 * cs.x) * dec;
                        if (t < 4) { o1a[t & 3] = p; o2a[t & 3] = q2; } else { o1b[t & 3] = p; o2b[t & 3] = q2; }
                    }
                    bf16* d = KNT + ((size_t)(b * 2048 + h * 256 + j) * 2048 + s);
                    *(u32x4*)d = pk8(o1a, o1b); *(u32x4*)(d + (size_t)128 * 2048) = pk8(o2a, o2b);
                }
            }
    }
};
struct EpiRetA {
    bf16* VS;
    DI void operator()(EPI_ARGS) const {
#pragma unroll
        for (int ai = 0; ai < 2; ++ai)
#pragma unroll
            for (int m = 0; m < 4; ++m) {
                const int r = u.r0 + ai * 128 + wr * 64 + m * 16 + fr;
#pragma unroll
                for (int bj = 0; bj < 2; ++bj)
                    *(u32x4*)(VS + ((size_t)u.aux * 512 + r) * 512 + 256 + bj * 128 + wc * 32 + fq * 8) = pk8(acc[ai][bj][m][0], acc[ai][bj][m][1]);
            }
    }
};
struct EpiRetP {
    bf16* PQ;
    DI void operator()(EPI_ARGS) const {
        asm volatile("" : "+v"(fr));
#pragma unroll
        for (int ai = 0; ai < 2; ++ai)
#pragma unroll
            for (int m = 0; m < 4; ++m) {
                const int r = ai * 128 + wr * 64 + m * 16 + fr;
#pragma unroll
                for (int bj = 0; bj < 2; ++bj) {
                    const int c = bj * 128 + wc * 32 + fq * 8; f32x4 a = acc[ai][bj][m][0], b2 = acc[ai][bj][m][1];
#pragma unroll
                    for (int i = 0; i < 4; ++i) {
                        a[i] = __uint_as_float(__float_as_uint(a[i]) & ~(unsigned)((r - c - i) >> 31)); b2[i] = __uint_as_float(__float_as_uint(b2[i]) & ~(unsigned)((r - c - 4 - i) >> 31)); }
                    *(u32x4*)(PQ + ((size_t)u.aux * 256 + r) * 512 + c) = pk8(a, b2);
                }
            }
    }
};
struct EpiRetO {
    bf16* O;
    DI void operator()(EPI_ARGS) const {
        const int g = u.aux, bh = g >> 3, sc = g & 7, b = bh >> 3, h = bh & 7;
#pragma unroll
        for (int ai = 0; ai < 2; ++ai)
#pragma unroll
            for (int m = 0; m < 4; ++m) {
                const int r = b * 2048 + sc * 256 + ai * 128 + wr * 64 + m * 16 + fr;
#pragma unroll
                for (int bj = 0; bj < 2; ++bj)
                    *(u32x4*)(O + (size_t)r * 4096 + h * 512 + u.r0 + bj * 128 + wc * 32 + fq * 8) = pk8(acc[ai][bj][m][0], acc[ai][bj][m][1]);
            }
    }
};
struct Frame {
    LAS unsigned char* lds;
    int tid, lane, wave, G, bid;
    unsigned char* ws;
    float* out;
    DI const float* inp(int i) const { const volatile LAS unsigned* t = (const volatile LAS unsigned*)(lds + 131072 + 2048);
        const unsigned lo = __builtin_amdgcn_readfirstlane(t[2 * i]), hi = __builtin_amdgcn_readfirstlane(t[2 * i + 1]); return (const float*)(((unsigned long long)hi << 32) | lo); }
};
#define WSP(T, off) ((T*)(F.ws + (off)))
#define LDS_WAIT() asm volatile("s_waitcnt lgkmcnt(0)" ::: "memory")
#define VM_WAIT() asm volatile("s_waitcnt vmcnt(0)" ::: "memory")
enum { I_X = 0, I_META, I_ABWIN, I_LOGDT, I_LRE, I_LIM, I_BRE, I_BIM, I_CRE, I_CIM, I_S5D, I_WGLU, I_GW2, I_GBG, I_GNG, I_ABWOUT, I_RWIN, I_RNG, I_RWOUT,
       I_LN1G, I_LN1B, I_LN2G, I_LN2B, I_ROUTER, I_MBIAS, I_MWG, I_MWU, I_MWD, I_SWG, I_SWU, I_SWD };

DI void p0_transpose_item(const float* W, int ldw, bf16* WT, int K, int k0, int n0, int drow0, LAS unsigned* T, int lane) {
    const int nq = lane & 15, kr = lane >> 4;
    const float* src = W + (size_t)(k0 + 2 * kr) * ldw + n0 + 4 * nq;
    f32x4 va[8], vb[8];
#pragma unroll
    for (int p = 0; p < 8; ++p) { va[p] = *(const f32x4*)(src + (size_t)(8 * p) * ldw); vb[p] = *(const f32x4*)(src + (size_t)(8 * p + 1) * ldw); }
#pragma unroll
    for (int p = 0; p < 8; ++p)
#pragma unroll
        for (int i = 0; i < 4; ++i) T[(4 * nq + i) * 33 + 4 * p + kr] = pk2(va[p][i], vb[p][i]);
    LDS_WAIT(); asm volatile("" ::: "memory");
    const int rr = lane >> 3, c = lane & 7;
#pragma unroll
    for (int j = 0; j < 8; ++j) { const int n = 8 * j + rr; const LAS unsigned* t = T + n * 33 + 4 * c;
        u32x4 o; o.x = t[0]; o.y = t[1]; o.z = t[2]; o.w = t[3];
        *(u32x4*)(WT + (size_t)(drow0 + n) * K + k0 + 8 * c) = o; }
    LDS_WAIT(); asm volatile("" ::: "memory");
}
DI void p0_dense_item(Frame& F, int it, LAS unsigned* scr) {
    constexpr int C0 = 32 * 64, C1 = 16 * 16, C2 = 32 * 32, C3 = 32 * 192;
    const float* W; int ldw, K, nblk; bf16* WT;
    if (it < C0) { W = F.inp(I_ABWIN); ldw = ABC; K = 2048; nblk = 64; WT = WSP(bf16, WS_WIN0T); }
    else if ((it -= C0) < C1) { W = F.inp(I_WGLU); ldw = 1024; K = 1024; nblk = 16; WT = WSP(bf16, WS_WGLUT); }
    else if ((it -= C1) < C2) { W = F.inp(I_ABWOUT); ldw = 2048; K = 2048; nblk = 32; WT = WSP(bf16, WS_WOUT0T); }
    else if ((it -= C2) < C3) { W = F.inp(I_RWIN); ldw = RETC; K = 2048; nblk = 192; WT = WSP(bf16, WS_WIN1T); }
    else { it -= C3; W = F.inp(I_RWOUT); ldw = 2048; K = 4096; nblk = 32; WT = WSP(bf16, WS_WOUT1T); }
    const int kb = it / nblk, nb = it % nblk;
    p0_transpose_item(W, ldw, WT, K, 64 * kb, 64 * nb, 64 * nb, scr, F.lane);
}
constexpr int P0_DENSE_ITEMS = 32 * 64 + 16 * 16 + 32 * 32 + 32 * 192 + 64 * 32;
constexpr int P0_MOE_ITEMS = 2 * NEX * 3 * 256;
DI void p0_moe_item(Frame& F, int it, LAS unsigned* scr) {
    const int l = it / (NEX * 768); int rem = it % (NEX * 768); const int e = rem / 768; rem %= 768; const int mat = rem / 256, k = rem % 256;
    if (mat < 2) {
        const float* W = (e < NE) ? F.inp(mat == 0 ? I_MWG : I_MWU) + (size_t)(l * NE + e) * 2048 * 512 : F.inp(mat == 0 ? I_SWG : I_SWU) + (size_t)l * 2048 * 512;
        bf16* WT = WSP(bf16, WS_WGU) + (size_t)(l * NEX + e) * 1024 * 2048;
        const int kb = k / 8, nb = k % 8, n0 = 64 * nb;
        p0_transpose_item(W, 512, WT, 2048, 64 * kb, n0, (n0 >> 7) * 256 + mat * 128 + (n0 & 127), scr, F.lane);
    } else {
        const float* W = (e < NE) ? F.inp(I_MWD) + (size_t)(l * NE + e) * 512 * 2048 : F.inp(I_SWD) + (size_t)l * 512 * 2048;
        bf16* WT = WSP(bf16, WS_WD) + (size_t)(l * NEX + e) * 2048 * 512;
        const int kb = k / 32, nb = k % 32;
        p0_transpose_item(W, 2048, WT, 512, 64 * kb, 64 * nb, 64 * nb, scr, F.lane);
    }
}
DI void p0_s5_group(Frame& F, int g) {
    LAS f32x2* POW = (LAS f32x2*)(F.lds);
    LAS f32x2* BB = (LAS f32x2*)(F.lds + 9216);
    LAS f32x2* CC = (LAS f32x2*)(F.lds + 9216 + 8192);
    LAS float* KD = (LAS float*)(F.lds + 9216 + 16384);
    LAS f32x2* ZS = (LAS f32x2*)(F.lds + 9216 + 32768);
    const int tid = F.tid;
    if (tid < 64) {
        const int p = tid; const float dt = expf(F.inp(I_LOGDT)[g]); const float lr = F.inp(I_LRE)[g * 64 + p], li = F.inp(I_LIM)[g * 64 + p];
        for (int k = 0; k <= 16; ++k) { const float mag = expf(lr * dt * (float)k); float sn, cs; sincosf(li * dt * (float)k, &sn, &cs); POW[k * 64 + p] = (f32x2){mag * cs, mag * sn}; }
        const f32x2 ab = POW[64 + p]; const float nr = ab.x - 1.0f, ni = ab.y, den = lr * lr + li * li;
        ZS[p] = (f32x2){(nr * lr + ni * li) / den, (ni * lr - nr * li) / den};
        const f32x2 a16 = POW[16 * 64 + p]; float* o = WSP(float, WS_A16) + (size_t)(g * 64 + p) * 2; o[0] = a16.x; o[1] = a16.y;
    }
    __syncthreads();
    for (int e = tid; e < 1024; e += NTHR) {
        const int p = e >> 4, c = e & 15; const f32x2 z = ZS[p]; const float br = F.inp(I_BRE)[(size_t)(g * 64 + p) * 16 + c], bi = F.inp(I_BIM)[(size_t)(g * 64 + p) * 16 + c];
        BB[p * 16 + c] = (f32x2){z.x * br - z.y * bi, z.x * bi + z.y * br};
        const int c2 = e >> 6, p2 = e & 63;
        CC[c2 * 64 + p2] = (f32x2){F.inp(I_CRE)[(size_t)(g * 16 + c2) * 64 + p2], F.inp(I_CIM)[(size_t)(g * 16 + c2) * 64 + p2]};
    }
    __syncthreads();
    for (int e = tid; e < 4096; e += NTHR) {
        const int dl = e >> 8, c = (e >> 4) & 15, c2 = e & 15; float s = 0.f;
        for (int p = 0; p < 64; ++p) { const f32x2 cc = CC[c * 64 + p], pw = POW[dl * 64 + p], bb = BB[p * 16 + c2];
            const float wr_ = cc.x * pw.x - cc.y * pw.y, wi_ = cc.x * pw.y + cc.y * pw.x; s += wr_ * bb.x - wi_ * bb.y; }
        KD[e] = s;
    }
    __syncthreads();
    unsigned* TMo = WSP(unsigned, WS_TM) + (size_t)g * 256 * 192;
    for (int e = tid; e < 256 * 192; e += NTHR) {
        const int row = e / 192, kp = (e % 192) * 2, tau = row >> 4, c = row & 15; float v[2];
#pragma unroll
        for (int q = 0; q < 2; ++q) { const int k = kp + q;
            if (k < 256) { const int s = k >> 4, c2 = k & 15; v[q] = (s <= tau) ? KD[((tau - s) << 8) + (c << 4) + c2] + ((s == tau && c == c2) ? F.inp(I_S5D)[g * 16 + c] : 0.f) : 0.f; }
            else { const int j = k - 256, p = j & 63; const f32x2 cc = CC[c * 64 + p], pw = POW[(tau + 1) * 64 + p];
                v[q] = (j < 64) ? (cc.x * pw.x - cc.y * pw.y) : -(cc.x * pw.y + cc.y * pw.x); } }
        TMo[e] = pk2(v[0], v[1]);
    }
    unsigned* BKo = WSP(unsigned, WS_BKT) + (size_t)g * 128 * 128;
    for (int e = tid; e < 128 * 128; e += NTHR) {
        const int j = e >> 7, kp = (e & 127) * 2, p = j & 63; float v[2];
#pragma unroll
        for (int q = 0; q < 2; ++q) { const int k = kp + q, s = k >> 4, c = k & 15; const f32x2 pw = POW[(15 - s) * 64 + p], bb = BB[p * 16 + c];
            v[q] = (j < 64) ? (pw.x * bb.x - pw.y * bb.y) : (pw.x * bb.y + pw.y * bb.x); }
        BKo[e] = pk2(v[0], v[1]);
    }
    __syncthreads();
}
DI void p0_prologue(Frame& F) {
    if (F.bid < 64) p0_s5_group(F, F.bid);
    LAS unsigned* scr = (LAS unsigned*)(F.lds + F.wave * 16384);
    const int gw = F.bid * NWAVES + F.wave, NGW = F.G * NWAVES;
    for (int it = gw; it < P0_DENSE_ITEMS; it += NGW) p0_dense_item(F, it, scr);
    for (int it = gw; it < P0_MOE_ITEMS; it += NGW) p0_moe_item(F, it, scr);
    const size_t gt = (size_t)F.bid * NTHR + F.tid, NGT = (size_t)F.G * NTHR;
    for (size_t e = gt; e < 16 * 2048; e += NGT) { const int n = (int)(e >> 11), k = (int)(e & 2047); WSP(bf16, WS_WIN0T)[(size_t)(4096 + n) * 2048 + k] = f2bf(F.inp(I_ABWIN)[(size_t)k * ABC + 4096 + n]); }
    for (size_t e = gt; e < 2 * 64 * 2048; e += NGT) { const int l = (int)(e >> 17), n = (int)((e >> 11) & 63), k = (int)(e & 2047);
        const float w = F.inp(I_ROUTER)[((size_t)l * 2048 + k) * 64 + n]; const bf16 hi = f2bf(w); const bf16 lo = f2bf(w - bf2f(hi));
        WSP(bf16, WS_RT)[((size_t)(l * 2 + 0) * 64 + n) * 2048 + k] = hi; WSP(bf16, WS_RT)[((size_t)(l * 2 + 1) * 64 + n) * 2048 + k] = lo; }
    for (size_t e = gt; e < (size_t)TR * 512; e += NGT) { const size_t r = e >> 9, c4 = (e & 511) * 4;
        const f32x4 v = (r < TM) ? *(const f32x4*)(F.inp(I_X) + r * 2048 + c4) : *(const f32x4*)(F.inp(I_META) + (r - TM) * 2048 + c4);
        u32x2 o; o.x = pk2(v[0], v[1]); o.y = pk2(v[2], v[3]); *(u32x2*)(WSP(bf16, WS_XB) + r * 2048 + c4) = o; }
    for (size_t e = gt; e < (size_t)2064 * 128; e += NGT) { const int pos = (int)(e >> 7), j = (int)(e & 127);
        const float inv = exp2f(-(float)j * (13.287712379549449f / 128.0f)); float sn, cs; sincosf((float)pos * inv, &sn, &cs); WSP(f32x2, WS_ROPE)[e] = (f32x2){cs, sn}; }
}

DI f32x4 skinny_tile(const bf16* A0, size_t lda, const bf16* Bt, size_t ldb, int K, int lane) {
    const int r = lane & 15, q = lane >> 4;
    const bf16* ap = A0 + (size_t)r * lda + 8 * q; const bf16* bp = Bt + (size_t)r * ldb + 8 * q;
    f32x4 acc0 = {0.f, 0.f, 0.f, 0.f}, acc1 = {0.f, 0.f, 0.f, 0.f};
    for (int k = 0; k < K; k += 128) {
        const bf16x8 a0 = *(const bf16x8*)(ap + k), a1 = *(const bf16x8*)(ap + k + 32), a2 = *(const bf16x8*)(ap + k + 64), a3 = *(const bf16x8*)(ap + k + 96);
        const bf16x8 b0 = *(const bf16x8*)(bp + k), b1 = *(const bf16x8*)(bp + k + 32), b2 = *(const bf16x8*)(bp + k + 64), b3 = *(const bf16x8*)(bp + k + 96);
        acc0 = MFMA16(a0, b0, acc0); acc1 = MFMA16(a1, b1, acc1); acc0 = MFMA16(a2, b2, acc0); acc1 = MFMA16(a3, b3, acc1);
    }
    return acc0 + acc1;
}

DI void s5_unit(Frame& F, int b, int g) {
    LAS float* Gs = (LAS float*)(F.lds);
    LAS bf16* Hb = (LAS bf16*)(F.lds + 66048);
    const int w = F.wave, lane = F.lane, r = lane & 15, q = lane >> 4;
    const bf16* Ub = WSP(bf16, WS_U) + (size_t)(b * 64 + g) * 2048 * 16;
    const bf16* Um = WSP(bf16, WS_UMETA) + (size_t)g * 256;
    const bf16* BK = WSP(bf16, WS_BKT) + (size_t)g * 128 * 256;
    const bf16* TMg = WSP(bf16, WS_TM) + (size_t)g * 256 * 384;
    {
        f32x4 acc[8], accm[8];
#pragma unroll
        for (int n = 0; n < 8; ++n) { acc[n] = (f32x4){0.f, 0.f, 0.f, 0.f}; accm[n] = (f32x4){0.f, 0.f, 0.f, 0.f}; }
#pragma unroll 2
        for (int ks = 0; ks < 8; ++ks) {
            const bf16x8 a = *(const bf16x8*)(Ub + (size_t)(16 * w + r) * 256 + 32 * ks + 8 * q);
            const bf16x8 am = *(const bf16x8*)(Um + 32 * ks + 8 * q);
#pragma unroll
            for (int n = 0; n < 8; ++n) { const bf16x8 bb = *(const bf16x8*)(BK + (size_t)(16 * n + r) * 256 + 32 * ks + 8 * q);
                acc[n] = MFMA16(a, bb, acc[n]); if (w == 0) accm[n] = MFMA16(am, bb, accm[n]); }
        }
#pragma unroll
        for (int n = 0; n < 8; ++n) {
#pragma unroll
            for (int i = 0; i < 4; ++i) Gs[(16 * w + 4 * q + i) * 128 + 16 * n + r] = acc[n][i];
            if (w == 0 && q == 0) Gs[128 * 128 + 16 * n + r] = accm[n][0];
        }
    }
    __syncthreads();
    if (w == 0) {
        const int p = lane; const float ar = WSP(float, WS_A16)[(size_t)(g * 64 + p) * 2], ai = WSP(float, WS_A16)[(size_t)(g * 64 + p) * 2 + 1];
        float hr = Gs[128 * 128 + p], hi = Gs[128 * 128 + 64 + p];
        for (int n = 0; n < 128; ++n) {
            Hb[n * 128 + p] = f2bf(hr); Hb[n * 128 + 64 + p] = f2bf(hi);
            const float gr = Gs[n * 128 + p], gi = Gs[n * 128 + 64 + p];
            const float nr = ar * hr - ai * hi + gr, ni = ar * hi + ai * hr + gi; hr = nr; hi = ni;
        }
    } else {
        for (int e = (w - 1) * 64 + lane; e < 16 * 128; e += 7 * 64) Hb[128 * 128 + e] = 0;
    }
    __syncthreads();
    bf16* Zo = WSP(bf16, WS_Z);
#pragma unroll 1
    for (int pass = 0; pass < (b == 0 ? 3 : 2); ++pass) {
        const bool meta = pass == 2; const int nbase = meta ? 2 * w : 8 * pass, ncnt = meta ? 2 : 8;
        f32x4 acc[8];
#pragma unroll
        for (int n = 0; n < 8; ++n) acc[n] = (f32x4){0.f, 0.f, 0.f, 0.f};
        const int arow = meta ? 128 + r : 16 * w + r;
#pragma unroll 2
        for (int ks = 0; ks < 12; ++ks) {
            bf16x8 a;
            if (ks < 8) a = meta ? *(const bf16x8*)(Um + 32 * ks + 8 * q) : *(const bf16x8*)(Ub + (size_t)arow * 256 + 32 * ks + 8 * q);
            else a = *(const LAS bf16x8*)(Hb + arow * 128 + 32 * (ks - 8) + 8 * q);
#pragma unroll
            for (int n = 0; n < 8; ++n) if (n < ncnt) { const bf16x8 bb = *(const bf16x8*)(TMg + (size_t)(16 * (nbase + n) + r) * 384 + 32 * ks + 8 * q); acc[n] = MFMA16(a, bb, acc[n]); }
        }
#pragma unroll
        for (int n = 0; n < 8; ++n) if (n < ncnt) {
            const int tau = nbase + n;
            if (!meta) {
#pragma unroll
                for (int i = 0; i < 4; ++i) Zo[((size_t)b * 2048 + 16 * (16 * w + 4 * q + i) + tau) * 1024 + g * 16 + r] = f2bf(gelu_tanh(acc[n][i]));
            } else if (q == 0) Zo[((size_t)TM + tau) * 1024 + g * 16 + r] = f2bf(gelu_tanh(acc[n][0]));
        }
    }
    __syncthreads();
}

DI float logsig16(float x) { return (fminf(x, 0.f) - log1pf(__expf(-fabsf(x)))) * 0.0625f; }
DI void gla_pre_unit(Frame& F, int b, int n, int h) {
    LAS float* GLs = (LAS float*)(F.lds);
    LAS float* W2s = (LAS float*)(F.lds + 4096);
    LAS float* CAR = (LAS float*)(F.lds + 12288);
    LAS bf16* KnT = (LAS bf16*)(F.lds + 16384);
    const int tid = F.tid, j = tid & 127, tq = tid >> 7;
    const size_t row0 = (size_t)b * 2048 + 64 * n;
    for (int e = tid; e < 1024; e += NTHR) GLs[e] = WSP(float, WS_GL)[row0 * 16 + e];
    for (int e = tid; e < 2048; e += NTHR) W2s[e] = F.inp(I_GW2)[(size_t)(e >> 7) * 512 + h * 128 + (e & 127)];
    const float bias = F.inp(I_GBG)[h * 128 + j];
    __syncthreads();
    float bl[16]; float run = 0.f;
#pragma unroll
    for (int i = 0; i < 16; ++i) { const int t = tq * 16 + i; float x = bias;
#pragma unroll
        for (int rr = 0; rr < 16; ++rr) x += GLs[t * 16 + rr] * W2s[rr * 128 + j];
        run += logsig16(x); bl[i] = run; }
    CAR[tq * 128 + j] = run;
    __syncthreads();
    float off = 0.f, tot = 0.f;
#pragma unroll
    for (int t2 = 0; t2 < 4; ++t2) { const float c = CAR[t2 * 128 + j]; tot += c; off += (t2 < tq) ? c : 0.f; }
    const bf16* Qr = WSP(bf16, WS_QRAW); const bf16* Kr = WSP(bf16, WS_KRAW); bf16* QSo = WSP(bf16, WS_QS); bf16* KNo = WSP(bf16, WS_KN);
    float kn[16];
#pragma unroll
    for (int i = 0; i < 16; ++i) { const size_t row = row0 + tq * 16 + i; const float bb = bl[i] + off, e = __expf(bb), ei = __expf(-bb);
        const float qv = bf2f(Qr[row * 512 + h * 128 + j]), kv = bf2f(Kr[row * 512 + h * 128 + j]);
        QSo[row * 512 + h * 128 + j] = f2bf(qv * e); kn[i] = kv * ei; KNo[row * 512 + h * 128 + j] = f2bf(kn[i]); }
    { u32x4 o0, o1; o0.x = pk2(kn[0], kn[1]); o0.y = pk2(kn[2], kn[3]); o0.z = pk2(kn[4], kn[5]); o0.w = pk2(kn[6], kn[7]);
      o1.x = pk2(kn[8], kn[9]); o1.y = pk2(kn[10], kn[11]); o1.z = pk2(kn[12], kn[13]); o1.w = pk2(kn[14], kn[15]);
      *(LAS u32x4*)(KnT + j * 64 + tq * 16) = o0; *(LAS u32x4*)(KnT + j * 64 + tq * 16 + 8) = o1; }
    if (tq == 0) WSP(float, WS_DC0)[(size_t)(b * 32 + n) * 512 + h * 128 + j] = __expf(tot);
    __syncthreads();
    {
        const int w = F.wave, lane = F.lane, r = lane & 15, q = lane >> 4;
        const bf16* VT = WSP(bf16, WS_VT0) + ((size_t)(b * 1024 + h * 256) * 2048 + 64 * n);
        bf16* STo = WSP(bf16, WS_ST0) + (size_t)((b * 4 + h) * 32 + n) * 256 * 128;
#pragma unroll
        for (int mi = 0; mi < 2; ++mi) {
            const int mt = 2 * w + mi;
            f32x4 acc[8];
#pragma unroll
            for (int nn = 0; nn < 8; ++nn) acc[nn] = (f32x4){0.f, 0.f, 0.f, 0.f};
#pragma unroll
            for (int ks = 0; ks < 2; ++ks) {
                const bf16x8 a = *(const bf16x8*)(VT + (size_t)(16 * mt + r) * 2048 + 32 * ks + 8 * q);
#pragma unroll
                for (int nn = 0; nn < 8; ++nn) { const bf16x8 bb = *(const LAS bf16x8*)(KnT + (16 * nn + r) * 64 + 32 * ks + 8 * q); acc[nn] = MFMA16(a, bb, acc[nn]); }
            }
#pragma unroll
            for (int nn = 0; nn < 8; ++nn)
#pragma unroll
                for (int i = 0; i < 4; ++i) STo[(size_t)(16 * mt + 4 * q + i) * 128 + 16 * nn + r] = f2bf(acc[nn][i]);
        }
    }
    __syncthreads();
}
DI void gla_meta_unit(Frame& F, int h) {
    LAS float* GLs = (LAS float*)(F.lds);
    LAS float* W2s = (LAS float*)(F.lds + 4096);
    LAS float* QSm = (LAS float*)(F.lds + 16384);
    LAS float* KNm = (LAS float*)(F.lds + 24576);
    LAS float* Vm = (LAS float*)(F.lds + 32768);
    LAS float* SC = (LAS float*)(F.lds + 49152);
    LAS float* Om = (LAS float*)(F.lds + 53248);
    LAS float* DCm = (LAS float*)(F.lds + 69632);
    const int tid = F.tid, j = tid & 127, tq = tid >> 7;
    const float* PM = WSP(float, WS_PMETA);
    for (int e = tid; e < 256; e += NTHR) GLs[e] = WSP(float, WS_GL)[(size_t)TM * 16 + e];
    for (int e = tid; e < 2048; e += NTHR) W2s[e] = F.inp(I_GW2)[(size_t)(e >> 7) * 512 + h * 128 + (e & 127)];
    for (int e = tid; e < 4096; e += NTHR) Vm[e] = PM[(size_t)(e >> 8) * ABC + 2048 + h * 256 + (e & 255)];
    __syncthreads();
    if (tq == 0) {
        const float bias = F.inp(I_GBG)[h * 128 + j]; float run = 0.f;
        for (int i = 0; i < 16; ++i) { float x = bias;
#pragma unroll
            for (int rr = 0; rr < 16; ++rr) x += GLs[i * 16 + rr] * W2s[rr * 128 + j];
            run += logsig16(x);
            QSm[i * 128 + j] = PM[(size_t)i * ABC + 1024 + h * 128 + j] * 0.08838834764831845f * __expf(run);
            KNm[i * 128 + j] = PM[(size_t)i * ABC + 1536 + h * 128 + j] * __expf(-run); }
        DCm[j] = __expf(run);
    }
    __syncthreads();
    {
        const float dc = DCm[j]; float* So = WSP(float, WS_SMETA0) + (size_t)h * 256 * 128;
        for (int d = 0; d < 64; ++d) { const int dv = tq * 64 + d; float s = 0.f;
#pragma unroll
            for (int i = 0; i < 16; ++i) s += KNm[i * 128 + j] * Vm[i * 256 + dv];
            So[(size_t)dv * 128 + j] = dc * s; }
    }
    if (tid < 256) { const int i = tid >> 4, s = tid & 15; float a = 0.f; for (int jj = 0; jj < 128; ++jj) a += QSm[i * 128 + jj] * KNm[s * 128 + jj]; SC[tid] = (s <= i) ? a : 0.f; }
    __syncthreads();
    { const int dv = tid & 255, ih = tid >> 8;
        for (int i2 = 0; i2 < 8; ++i2) { const int i = ih * 8 + i2; float o = 0.f;
#pragma unroll
            for (int s = 0; s < 16; ++s) o += SC[i * 16 + s] * Vm[s * 256 + dv];
            Om[i * 256 + dv] = o; } }
    __syncthreads();
    for (int rr = 0; rr < 2; ++rr) {
        const int i = F.wave * 2 + rr; float v[4], s = 0.f;
#pragma unroll
        for (int k = 0; k < 4; ++k) { v[k] = Om[i * 256 + F.lane + 64 * k]; s += v[k]; }
        const float mean = wave_sum(s) * (1.f / 256.f); float s2 = 0.f;
#pragma unroll
        for (int k = 0; k < 4; ++k) { v[k] -= mean; s2 += v[k] * v[k]; }
        const float rstd = 1.f / sqrtf(wave_sum(s2) * (1.f / 256.f) + LN_EPS);
#pragma unroll
        for (int k = 0; k < 4; ++k) { const int dv = F.lane + 64 * k;
            const float gate = siluf_(PM[(size_t)i * ABC + 3072 + h * 256 + dv]);
            WSP(bf16, WS_MIXED0)[(size_t)(TM + i) * 2048 + 1024 + h * 256 + dv] = f2bf(v[k] * rstd * F.inp(I_GNG)[h * 256 + dv] * gate); }
    }
    __syncthreads();
}
DI void gla_scan(Frame& F) {
    const size_t gt = (size_t)F.bid * NTHR + F.tid, NGT = (size_t)F.G * NTHR;
    for (size_t e = gt; e < (size_t)16 * 256 * 32; e += NGT) {
        const int bh = (int)(e >> 13), dv = (int)((e >> 5) & 255), dk = (int)(e & 31) * 4, b = bh >> 2, h = bh & 3;
        f32x4 s = *(const f32x4*)(WSP(float, WS_SMETA0) + ((size_t)h * 256 + dv) * 128 + dk);
        bf16* st = WSP(bf16, WS_ST0) + ((size_t)bh * 32 * 256 + dv) * 128 + dk;
        const float* dcp = WSP(float, WS_DC0) + (size_t)b * 32 * 512 + h * 128 + dk;
        for (int n = 0; n < 32; ++n) {
            u32x2* p = (u32x2*)(st + (size_t)n * 256 * 128); const u32x2 c = *p; const f32x4 dc = *(const f32x4*)(dcp + (size_t)n * 512);
            u32x2 o; o.x = pk2(s[0], s[1]); o.y = pk2(s[2], s[3]); *p = o;
            s[0] = dc[0] * (s[0] + bflo(c.x)); s[1] = dc[1] * (s[1] + bfhi(c.x)); s[2] = dc[2] * (s[2] + bflo(c.y)); s[3] = dc[3] * (s[3] + bfhi(c.y));
        }
    }
}
DI void gla_out_unit(Frame& F, int b, int n, int h) {
    LAS float* STA = (LAS float*)(F.lds);
    const int w = F.wave, lane = F.lane, r = lane & 15, q = lane >> 4, rb = w & 3, dh = w >> 2;
    const size_t row0 = (size_t)b * 2048 + 64 * n;
    const bf16* QSp = WSP(bf16, WS_QS) + row0 * 512 + h * 128; const bf16* KNp = WSP(bf16, WS_KN) + row0 * 512 + h * 128;
    const bf16* VT = WSP(bf16, WS_VT0) + ((size_t)(b * 1024 + h * 256 + dh * 128) * 2048 + 64 * n);
    const bf16* STp = WSP(bf16, WS_ST0) + ((size_t)((b * 4 + h) * 32 + n) * 256 + dh * 128) * 128;
    bf16x8 qf[4];
#pragma unroll
    for (int ks = 0; ks < 4; ++ks) qf[ks] = *(const bf16x8*)(QSp + (size_t)(16 * rb + r) * 512 + 32 * ks + 8 * q);
    f32x4 PT[4];
#pragma unroll
    for (int kb = 0; kb < 4; ++kb) { PT[kb] = (f32x4){0.f, 0.f, 0.f, 0.f};
        if (kb <= rb) {
#pragma unroll
            for (int ks = 0; ks < 4; ++ks) { const bf16x8 kf = *(const bf16x8*)(KNp + (size_t)(16 * kb + r) * 512 + 32 * ks + 8 * q); PT[kb] = MFMA16(kf, qf[ks], PT[kb]); }
            if (kb == rb) {
#pragma unroll
                for (int i = 0; i < 4; ++i) PT[kb][i] = (4 * q + i <= r) ? PT[kb][i] : 0.f; }
        } }
    f32x4 acc[8];
#pragma unroll
    for (int nn = 0; nn < 8; ++nn) acc[nn] = (f32x4){0.f, 0.f, 0.f, 0.f};
#pragma unroll
    for (int ks = 0; ks < 4; ++ks)
#pragma unroll
        for (int nn = 0; nn < 8; ++nn) { const bf16x8 sf = *(const bf16x8*)(STp + (size_t)(16 * nn + r) * 128 + 32 * ks + 8 * q); acc[nn] = MFMA16(qf[ks], sf, acc[nn]); }
#pragma unroll
    for (int s2 = 0; s2 < 2; ++s2) if (2 * s2 <= rb) {
        u32x4 pa; pa.x = pk2(PT[2 * s2][0], PT[2 * s2][1]); pa.y = pk2(PT[2 * s2][2], PT[2 * s2][3]); pa.z = pk2(PT[2 * s2 + 1][0], PT[2 * s2 + 1][1]); pa.w = pk2(PT[2 * s2 + 1][2], PT[2 * s2 + 1][3]);
        const bf16x8 af = __builtin_bit_cast(bf16x8, pa);
#pragma unroll
        for (int nn = 0; nn < 8; ++nn) { const bf16* vp = VT + (size_t)(16 * nn + r) * 2048 + 32 * s2 + 4 * q;
            const u32x2 v0 = *(const u32x2*)vp, v1 = *(const u32x2*)(vp + 16); u32x4 vb; vb.x = v0.x; vb.y = v0.y; vb.z = v1.x; vb.w = v1.y;
            acc[nn] = MFMA16(af, __builtin_bit_cast(bf16x8, vb), acc[nn]); }
    }
    float sm[4], sq[4];
#pragma unroll
    for (int i = 0; i < 4; ++i) { float a = 0.f, c = 0.f;
#pragma unroll
        for (int nn = 0; nn < 8; ++nn) { a += acc[nn][i]; c += acc[nn][i] * acc[nn][i]; }
#pragma unroll
        for (int o = 1; o < 16; o <<= 1) { a += __shfl_xor(a, o); c += __shfl_xor(c, o); }
        sm[i] = a; sq[i] = c; }
    if (r == 0) {
#pragma unroll
        for (int i = 0; i < 4; ++i) { STA[(dh * 64 + 16 * rb + 4 * q + i) * 2] = sm[i]; STA[(dh * 64 + 16 * rb + 4 * q + i) * 2 + 1] = sq[i]; } }
    __syncthreads();
    const bf16* Rp = WSP(bf16, WS_R); bf16* MX = WSP(bf16, WS_MIXED0);
#pragma unroll
    for (int i = 0; i < 4; ++i) {
        const int rl = 16 * rb + 4 * q + i; const float s = STA[rl * 2] + STA[(64 + rl) * 2], s2 = STA[rl * 2 + 1] + STA[(64 + rl) * 2 + 1];
        const float mean = s * (1.f / 256.f), var = fmaxf(s2 * (1.f / 256.f) - mean * mean, 0.f), rstd = 1.f / sqrtf(var + LN_EPS);
        const size_t row = row0 + rl;
#pragma unroll
        for (int nn = 0; nn < 8; ++nn) { const int dv = h * 256 + dh * 128 + 16 * nn + r;
            MX[row * 2048 + 1024 + dv] = f2bf((acc[nn][i] - mean) * rstd * F.inp(I_GNG)[dv] * bf2f(Rp[row * 1024 + dv])); }
    }
    __syncthreads();
}
DI void p1_skinny(Frame& F) {
    const int gw = F.bid * NWAVES + F.wave, NGW = F.G * NWAVES, lane = F.lane, c = lane & 15, q = lane >> 4;
    const bf16* XB = WSP(bf16, WS_XB); const bf16* WT = WSP(bf16, WS_WIN0T);
    for (int t = gw; t < 257 + 512; t += NGW) {
        if (t < 257) {
            const f32x4 a = skinny_tile(XB + (size_t)TM * 2048, 2048, WT + (size_t)t * 16 * 2048, 2048, 2048, lane);
#pragma unroll
            for (int i = 0; i < 4; ++i) { const int tok = 4 * q + i; WSP(float, WS_PMETA)[(size_t)tok * ABC + t * 16 + c] = a[i];
                if (t < 64) WSP(bf16, WS_UMETA)[(size_t)(t * 16 + tok) * 16 + c] = f2bf(a[i]);
                if (t == 256) WSP(float, WS_GL)[(size_t)(TM + tok) * 16 + c] = a[i]; }
        } else {
            const int rbk = t - 257;
            const f32x4 a = skinny_tile(XB + (size_t)rbk * 16 * 2048, 2048, WT + (size_t)4096 * 2048, 2048, 2048, lane);
#pragma unroll
            for (int i = 0; i < 4; ++i) WSP(float, WS_GL)[(size_t)(rbk * 16 + 4 * q + i) * 16 + c] = a[i];
        }
    }
}
DI void glu_meta_skinny(Frame& F) {
    const int gw = F.bid * NWAVES + F.wave, NGW = F.G * NWAVES, lane = F.lane, c = lane & 15, q = lane >> 4;
    const bf16* Z = WSP(bf16, WS_Z);
    for (int t = gw; t < 64; t += NGW) {
        const f32x4 a = skinny_tile(Z + (size_t)TM * 1024, 1024, WSP(bf16, WS_WGLUT) + (size_t)t * 16 * 1024, 1024, 1024, lane);
#pragma unroll
        for (int i = 0; i < 4; ++i) { const size_t row = TM + 4 * q + i; const int col = t * 16 + c;
            WSP(bf16, WS_MIXED0)[row * 2048 + col] = f2bf(bf2f(Z[row * 1024 + col]) * sigmoidf_(a[i])); }
    }
}
DI void out0_meta_skinny(Frame& F) {
    const int gw = F.bid * NWAVES + F.wave, NGW = F.G * NWAVES, lane = F.lane, c = lane & 15, q = lane >> 4;
    for (int t = gw; t < 128; t += NGW) {
        const f32x4 a = skinny_tile(WSP(bf16, WS_MIXED0) + (size_t)TM * 2048, 2048, WSP(bf16, WS_WOUT0T) + (size_t)t * 16 * 2048, 2048, 2048, lane);
#pragma unroll
        for (int i = 0; i < 4; ++i) { const int tok = 4 * q + i, col = t * 16 + c; WSP(float, WS_Y0)[(size_t)(TM + tok) * 2048 + col] = a[i] + ALPHA * F.inp(I_META)[(size_t)tok * 2048 + col]; }
    }
}
DI void kv1_meta_skinny(Frame& F) {
    const int gw = F.bid * NWAVES + F.wave, NGW = F.G * NWAVES, lane = F.lane, c = lane & 15, q = lane >> 4;
    for (int t = gw; t < 384; t += NGW) {
        const f32x4 a = skinny_tile(WSP(bf16, WS_H2B) + (size_t)TM * 2048, 2048, WSP(bf16, WS_WIN1T) + (size_t)(2048 + t * 16) * 2048, 2048, 2048, lane);
#pragma unroll
        for (int i = 0; i < 4; ++i) WSP(float, WS_KVMETA)[(size_t)(4 * q + i) * 6144 + t * 16 + c] = a[i];
    }
}

DI void ln_router_phase(Frame& F, int l, int ntok, int cbank) {
    const int lane = F.lane, r = lane & 15, q = lane >> 4, w = F.wave;
    LAS float* PART = (LAS float*)(F.lds);
    LAS float* Ss = (LAS float*)(F.lds + 32768);
    LAS float* SBs = (LAS float*)(F.lds + 36864);
    LAS float* GSs = (LAS float*)(F.lds + 40960);
    const float* Y0 = WSP(float, WS_Y0); float* H1F = WSP(float, WS_H1F); bf16* H1B = WSP(bf16, WS_H1B);
    const float* gam = F.inp(I_LN1G) + (size_t)l * 2048; const float* bet = F.inp(I_LN1B) + (size_t)l * 2048;
    const bf16* RH = WSP(bf16, WS_RT) + (size_t)(l * 2 + 0) * 64 * 2048; const bf16* RL = WSP(bf16, WS_RT) + (size_t)(l * 2 + 1) * 64 * 2048;
    const float* mbias = F.inp(I_MBIAS) + l * 64;
    unsigned* cnt = WSP(unsigned, WS_CTL) + CW_CNT + 128 * cbank;
    int* ROWIDX = WSP(int, WS_ROWIDX); int* EIDX = WSP(int, WS_ROUTE); int* EPOS = EIDX + TR * 8; float* EW = (float*)(EPOS + TR * 8);
    for (int t = F.bid; t * 16 < ntok; t += F.G) {
#pragma unroll
        for (int rr = 0; rr < 2; ++rr) {
            const size_t row = (size_t)t * 16 + 2 * w + rr;
            const f32x4* xr = (const f32x4*)(Y0 + row * 2048) + lane; f32x4 v[8]; float s = 0.f;
#pragma unroll
            for (int k = 0; k < 8; ++k) { v[k] = xr[64 * k]; s += (v[k][0] + v[k][1]) + (v[k][2] + v[k][3]); }
            const float mean = wave_sum(s) * (1.f / 2048.f); float s2 = 0.f;
#pragma unroll
            for (int k = 0; k < 8; ++k) { v[k] = v[k] - mean; s2 += (v[k][0] * v[k][0] + v[k][1] * v[k][1]) + (v[k][2] * v[k][2] + v[k][3] * v[k][3]); }
            const float rstd = 1.f / sqrtf(wave_sum(s2) * (1.f / 2048.f) + LN_EPS);
#pragma unroll
            for (int k = 0; k < 8; ++k) { const f32x4 g4 = *((const f32x4*)gam + lane + 64 * k), b4 = *((const f32x4*)bet + lane + 64 * k);
                const f32x4 y = v[k] * rstd * g4 + b4; *((f32x4*)(H1F + row * 2048) + lane + 64 * k) = y;
                u32x2 o; o.x = pk2(y[0], y[1]); o.y = pk2(y[2], y[3]); *((u32x2*)(H1B + row * 2048) + lane + 64 * k) = o; }
        }
        VM_WAIT(); __syncthreads();
        f32x4 acc[4];
#pragma unroll
        for (int n = 0; n < 4; ++n) acc[n] = (f32x4){0.f, 0.f, 0.f, 0.f};
        const float* ap = H1F + ((size_t)t * 16 + r) * 2048 + 256 * w + 8 * q;
        const bf16* rh = RH + (size_t)r * 2048 + 256 * w + 8 * q; const bf16* rl = RL + (size_t)r * 2048 + 256 * w + 8 * q;
#pragma unroll 4
        for (int ks = 0; ks < 8; ++ks) {
            const f32x4 x0 = *(const f32x4*)(ap + 32 * ks), x1 = *(const f32x4*)(ap + 32 * ks + 4);
            u32x4 hi, lo;
            hi.x = pk2(x0[0], x0[1]); hi.y = pk2(x0[2], x0[3]); hi.z = pk2(x1[0], x1[1]); hi.w = pk2(x1[2], x1[3]);
            lo.x = pk2(x0[0] - bflo(hi.x), x0[1] - bfhi(hi.x)); lo.y = pk2(x0[2] - bflo(hi.y), x0[3] - bfhi(hi.y));
            lo.z = pk2(x1[0] - bflo(hi.z), x1[1] - bfhi(hi.z)); lo.w = pk2(x1[2] - bflo(hi.w), x1[3] - bfhi(hi.w));
            const bf16x8 ah = __builtin_bit_cast(bf16x8, hi), al = __builtin_bit_cast(bf16x8, lo);
#pragma unroll
            for (int n = 0; n < 4; ++n) { const bf16x8 bh = *(const bf16x8*)(rh + (size_t)(16 * n) * 2048 + 32 * ks), bl = *(const bf16x8*)(rl + (size_t)(16 * n) * 2048 + 32 * ks);
                acc[n] = MFMA16(ah, bh, acc[n]); acc[n] = MFMA16(al, bh, acc[n]); acc[n] = MFMA16(ah, bl, acc[n]); }
        }
#pragma unroll
        for (int n = 0; n < 4; ++n)
#pragma unroll
            for (int i = 0; i < 4; ++i) PART[(w * 16 + 4 * q + i) * 64 + 16 * n + r] = acc[n][i];
        __syncthreads();
#pragma unroll
        for (int oo = 0; oo < 2; ++oo) { const int o = F.tid * 2 + oo; float a = 0.f;
#pragma unroll
            for (int ww = 0; ww < 8; ++ww) a += PART[ww * 1024 + o];
            const float sg = sigmoidf_(a); Ss[o] = sg; SBs[o] = sg + mbias[o & 63]; }
        __syncthreads();
        if (w == 0) {
            const int row = t * 16 + r;
#pragma unroll
            for (int gg = 0; gg < 2; ++gg) { float m1 = -INFINITY, m2 = -INFINITY;
                for (int k = 0; k < 8; ++k) { const float x = SBs[r * 64 + 16 * q + 8 * gg + k]; if (x > m1) { m2 = m1; m1 = x; } else if (x > m2) m2 = x; }
                GSs[r * 8 + 2 * q + gg] = m1 + m2; }
            LDS_WAIT(); asm volatile("" ::: "memory");
            float gs[8];
#pragma unroll
            for (int k = 0; k < 8; ++k) gs[k] = GSs[r * 8 + k];
            bool gsel[2];
#pragma unroll
            for (int gg = 0; gg < 2; ++gg) { const int gi = 2 * q + gg; int rank = 0; float mine = 0.f;
#pragma unroll
                for (int k = 0; k < 8; ++k) mine = (k == gi) ? gs[k] : mine;
#pragma unroll
                for (int k = 0; k < 8; ++k) rank += (gs[k] > mine || (gs[k] == mine && k < gi)) ? 1 : 0;
                gsel[gg] = rank < 4; }
#pragma unroll
            for (int gg = 0; gg < 2; ++gg) if (!gsel[gg]) { for (int k = 0; k < 8; ++k) SBs[r * 64 + 16 * q + 8 * gg + k] = -INFINITY; }
            LDS_WAIT(); asm volatile("" ::: "memory");
            int me0 = 0, me1 = 0; float mw0 = 0.f, mw1 = 0.f, wsum = 0.f;
            for (int kk = 0; kk < 8; ++kk) {
                float bv = -INFINITY; int bi = 16 * q;
                for (int k = 0; k < 16; ++k) { const float x = SBs[r * 64 + 16 * q + k]; if (x > bv) { bv = x; bi = 16 * q + k; } }
#pragma unroll
                for (int o = 16; o < 64; o <<= 1) { const float ov = __shfl_xor(bv, o); const int oi = __shfl_xor(bi, o); if (ov > bv || (ov == bv && oi < bi)) { bv = ov; bi = oi; } }
                const float wv = Ss[r * 64 + bi]; wsum += wv;
                if ((bi >> 4) == q) SBs[r * 64 + bi] = -INFINITY;
                if ((kk >> 1) == q) { if (kk & 1) { me1 = bi; mw1 = wv; } else { me0 = bi; mw0 = wv; } }
                LDS_WAIT(); asm volatile("" ::: "memory");
            }
            if (row < ntok) {
                const float sc = 2.5f / wsum;
                const unsigned p0 = atomicAdd(cnt + me0, 1u), p1 = atomicAdd(cnt + me1, 1u);
                ROWIDX[(size_t)me0 * TRP + p0] = row; ROWIDX[(size_t)me1 * TRP + p1] = row;
                EIDX[row * 8 + 2 * q] = me0; EIDX[row * 8 + 2 * q + 1] = me1; EPOS[row * 8 + 2 * q] = (int)p0; EPOS[row * 8 + 2 * q + 1] = (int)p1;
                EW[row * 8 + 2 * q] = mw0 * sc; EW[row * 8 + 2 * q + 1] = mw1 * sc;
                if (q == 0) ROWIDX[(size_t)NE * TRP + row] = row;
            }
        }
        __syncthreads();
    }
}
DI int moe_tables(Frame& F, int l, int ntok, volatile LAS int* TP, volatile LAS int* CN, volatile LAS int* LST) {
    if (F.tid < NEX) CN[F.tid] = (F.tid < NE) ? (int)__hip_atomic_load(WSP(unsigned, WS_CTL) + CW_CNT + 128 * l + F.tid, RLX_AGENT) : ntok;
    __syncthreads();
    if (F.tid == 0) {
        int a = 0; for (int e = 0; e < NEX; ++e) { TP[e] = a; a += (CN[e] + 255) >> 8; } TP[NEX] = a;
        const int v = F.bid & 7; int n = 0, load[8];
#pragma unroll
        for (int k = 0; k < 8; ++k) load[k] = 0;
        for (int e = 0; e < NE; ++e) { const int te = TP[e + 1] - TP[e];
#pragma unroll
            for (int k = 0; k < 8; ++k) load[k] += ((e & 7) == k) ? te : 0;
            if ((e & 7) == v) for (int j = 0; j < te; ++j) LST[n++] = (e << 16) | (TP[e] + j); }
        const int tsh = TP[NEX] - TP[NE];
        for (int sidx = 0; sidx < tsh; ++sidx) { int best = 0, bl = load[0];
#pragma unroll
            for (int k = 1; k < 8; ++k) if (load[k] < bl) { bl = load[k]; best = k; }
#pragma unroll
            for (int k = 0; k < 8; ++k) load[k] += (k == best) ? 1 : 0;
            if (best == v) LST[n++] = (NE << 16) | (TP[NE] + sidx); }
        LST[1023] = n;
    }
    __syncthreads();
    return __builtin_amdgcn_readfirstlane(LST[1023]);
}
DI void combine_ln_phase(Frame& F, int l, int ntok, volatile LAS int* TP) {
    const int gw = F.bid * NWAVES + F.wave, NGW = F.G * NWAVES, lane = F.lane;
    const float* H1F = WSP(float, WS_H1F); const bf16* YB = WSP(bf16, WS_YBUF);
    const int* EIDX = WSP(int, WS_ROUTE); const int* EPOS = EIDX + TR * 8; const float* EW = (const float*)(EPOS + TR * 8);
    const float* gam = F.inp(I_LN2G) + (size_t)l * 2048; const float* bet = F.inp(I_LN2B) + (size_t)l * 2048;
    for (int row = gw; row < ntok; row += NGW) {
        f32x4 v[8];
#pragma unroll
        for (int k = 0; k < 8; ++k) v[k] = ALPHA * *((const f32x4*)(H1F + (size_t)row * 2048) + lane + 64 * k);
        for (int kk = 0; kk < 9; ++kk) {
            int slot; float w;
            if (kk < 8) { const int e = EIDX[row * 8 + kk]; slot = TP[e] * 256 + EPOS[row * 8 + kk]; w = EW[row * 8 + kk]; } else { slot = TP[NE] * 256 + row; w = 1.f; }
            const u32x2* yp = (const u32x2*)(YB + (size_t)slot * 2048) + lane;
#pragma unroll
            for (int k = 0; k < 8; ++k) { const u32x2 y = yp[64 * k]; v[k][0] += w * bflo(y.x); v[k][1] += w * bfhi(y.x); v[k][2] += w * bflo(y.y); v[k][3] += w * bfhi(y.y); }
        }
        float s = 0.f;
#pragma unroll
        for (int k = 0; k < 8; ++k) s += (v[k][0] + v[k][1]) + (v[k][2] + v[k][3]);
        const float mean = wave_sum(s) * (1.f / 2048.f); float s2 = 0.f;
#pragma unroll
        for (int k = 0; k < 8; ++k) { v[k] = v[k] - mean; s2 += (v[k][0] * v[k][0] + v[k][1] * v[k][1]) + (v[k][2] * v[k][2] + v[k][3] * v[k][3]); }
        const float rstd = 1.f / sqrtf(wave_sum(s2) * (1.f / 2048.f) + LN_EPS);
#pragma unroll
        for (int k = 0; k < 8; ++k) { const f32x4 g4 = *((const f32x4*)gam + lane + 64 * k), b4 = *((const f32x4*)bet + lane + 64 * k);
            const f32x4 y = v[k] * rstd * g4 + b4;
            if (l == 0) { *((f32x4*)(WSP(float, WS_H2F) + (size_t)row * 2048) + lane + 64 * k) = y;
                u32x2 o; o.x = pk2(y[0], y[1]); o.y = pk2(y[2], y[3]); *((u32x2*)(WSP(bf16, WS_H2B) + (size_t)row * 2048) + lane + 64 * k) = o; }
            else *((f32x4*)(F.out + (size_t)row * 2048) + lane + 64 * k) = y; }
    }
}
DI void ret_scan(Frame& F) {
    const size_t gt = (size_t)F.bid * NTHR + F.tid, NGT = (size_t)F.G * NTHR;
    const float* KV = WSP(float, WS_KVMETA); const f32x2* rope = WSP(f32x2, WS_ROPE);
    for (size_t e = gt; e < (size_t)32 * 512 * 32; e += NGT) {
        const int bh = (int)(e >> 14), dv = (int)((e >> 5) & 511), dk0 = (int)(e & 31) * 8, h = bh & 7;
        const float l2g = lg2gamma(h), g256 = exp2f(256.f * l2g);
        float s[8];
#pragma unroll
        for (int i = 0; i < 8; ++i) s[i] = 0.f;
        for (int m = 0; m < 16; ++m) {
            const float vm = KV[(size_t)m * 6144 + 2048 + h * 512 + dv] * 0.0625f * exp2f((float)(15 - m) * l2g);
#pragma unroll
            for (int i = 0; i < 8; ++i) { const int dk = dk0 + i, j = dk & 127; const f32x2 cs = rope[(size_t)m * 128 + j];
                const float k1 = KV[(size_t)m * 6144 + h * 256 + j], k2 = KV[(size_t)m * 6144 + h * 256 + 128 + j];
                const float kr = (dk < 128) ? (k1 * cs.x - k2 * cs.y) : (k1 * cs.y + k2 * cs.x);
                s[i] += kr * vm; }
        }
        bf16* vs = WSP(bf16, WS_VS) + ((size_t)bh * 8 * 512 + dv) * 512 + 256 + dk0;
        for (int sc = 0; sc < 8; ++sc) {
            u32x4* p = (u32x4*)(vs + (size_t)sc * 512 * 512); const u32x4 c = *p;
            u32x4 o; o.x = pk2(s[0], s[1]); o.y = pk2(s[2], s[3]); o.z = pk2(s[4], s[5]); o.w = pk2(s[6], s[7]); *p = o;
            s[0] = g256 * (s[0] + bflo(c.x)); s[1] = g256 * (s[1] + bfhi(c.x)); s[2] = g256 * (s[2] + bflo(c.y)); s[3] = g256 * (s[3] + bfhi(c.y));
            s[4] = g256 * (s[4] + bflo(c.z)); s[5] = g256 * (s[5] + bfhi(c.z)); s[6] = g256 * (s[6] + bflo(c.w)); s[7] = g256 * (s[7] + bfhi(c.w));
        }
    }
}
DI void ret_norm_phase(Frame& F) {
    const int gw = F.bid * NWAVES + F.wave, NGW = F.G * NWAVES, lane = F.lane;
    const bf16* O = WSP(bf16, WS_O1); const bf16* GT = WSP(bf16, WS_GATE1); bf16* MX = WSP(bf16, WS_MIXED1);
    for (int row = gw; row < TM; row += NGW) {
#pragma unroll 2
        for (int h = 0; h < 8; ++h) {
            const size_t off = (size_t)row * 4096 + h * 512 + 8 * lane;
            const u32x4 o = *(const u32x4*)(O + off), g = *(const u32x4*)(GT + off);
            float v[8] = {bflo(o.x), bfhi(o.x), bflo(o.y), bfhi(o.y), bflo(o.z), bfhi(o.z), bflo(o.w), bfhi(o.w)};
            const float gv[8] = {bflo(g.x), bfhi(g.x), bflo(g.y), bfhi(g.y), bflo(g.z), bfhi(g.z), bflo(g.w), bfhi(g.w)};
            float s = 0.f;
#pragma unroll
            for (int i = 0; i < 8; ++i) s += v[i];
            const float mean = wave_sum(s) * (1.f / 512.f); float s2 = 0.f;
#pragma unroll
            for (int i = 0; i < 8; ++i) { v[i] -= mean; s2 += v[i] * v[i]; }
            const float rstd = 1.f / sqrtf(wave_sum(s2) * (1.f / 512.f) + LN_EPS);
            const f32x4 g0 = *(const f32x4*)(F.inp(I_RNG) + h * 512 + 8 * lane), g1 = *(const f32x4*)(F.inp(I_RNG) + h * 512 + 8 * lane + 4);
            u32x4 w; w.x = pk2(v[0] * rstd * g0[0] * gv[0], v[1] * rstd * g0[1] * gv[1]); w.y = pk2(v[2] * rstd * g0[2] * gv[2], v[3] * rstd * g0[3] * gv[3]);
            w.z = pk2(v[4] * rstd * g1[0] * gv[4], v[5] * rstd * g1[1] * gv[5]); w.w = pk2(v[6] * rstd * g1[2] * gv[6], v[7] * rstd * g1[3] * gv[7]);
            *(u32x4*)(MX + off) = w;
        }
    }
}
struct Args { const float* in[31]; float* out; unsigned char* ws; int ph_lo, ph_hi, li, pad; };
constexpr int NPHASE = 21;

__global__ void __launch_bounds__(NTHR, 2) mk_fwd(Args args) {
    extern __shared__ __attribute__((aligned(16))) unsigned char lds_raw[];
    Frame F;
    F.lds = (LAS unsigned char*)lds_raw;
    F.tid = threadIdx.x; F.lane = F.tid & 63; F.wave = __builtin_amdgcn_readfirstlane(F.tid >> 6);
    F.G = gridDim.x; F.bid = blockIdx.x; F.ws = args.ws; F.out = args.out;
    volatile LAS unsigned* MISC = (volatile LAS unsigned*)(F.lds + MISC_OFF);
    volatile LAS int* TP = (volatile LAS int*)(F.lds + MISC_OFF + 256);
    volatile LAS int* CN = (volatile LAS int*)(F.lds + MISC_OFF + 640);
    volatile LAS int* LST = (volatile LAS int*)(F.lds + MISC_OFF + 4096);
    for (int u = F.tid; u < (LDS_BYTES - MISC_OFF) / 4; u += NTHR) MISC[u] = 0u;
    __syncthreads();
    if (F.tid < 31) { const unsigned long long p = (unsigned long long)args.in[F.tid]; MISC[512 + 2 * F.tid] = (unsigned)p; MISC[512 + 2 * F.tid + 1] = (unsigned)(p >> 32); }
    __syncthreads();
    XcdBarrier bar = xcd_barrier_post(WSP(unsigned, WS_CTL) + CW_BAR + args.li * XCD_BAR_WORDS, MISC + 8);
    const int lo = args.ph_lo, hi = args.ph_hi;
#ifndef PHMASK
#define PHMASK 0x1fffff
#endif
#define IN(k) (((PHMASK >> (k)) & 1) && lo <= (k) && (k) < hi)
#define SEAM(k) do { if (IN(k) && IN((k) + 1)) xcd_barrier(bar); } while (0)
    LAS unsigned char* ring = F.lds;
    const int G = F.G, bid = F.bid;

    if (IN(0)) { p0_prologue(F); }
    SEAM(0);
    if (IN(1)) {
        p1_skinny(F);
        __syncthreads();
        { DenseSched S; S.init(WSP(bf16, WS_XB), 4096, WSP(bf16, WS_WIN0T), 4096, 2048, 32, 8, 0, 4, 12, G, bid);
          EpiIn0 E{WSP(bf16, WS_U), WSP(bf16, WS_QRAW), WSP(bf16, WS_KRAW), WSP(bf16, WS_R)};
          pg8::gemm_phase<EpiIn0, DenseSched, false>(ring, S, E); }
        { DenseSched S; S.init(WSP(bf16, WS_XB), 4096, WSP(bf16, WS_WIN0T), 4096, 2048, 32, 4, 8, 0, 0, G, (bid + G / 2) % G);
          EpiVT0 E{WSP(bf16, WS_VT0)};
          pg8::gemm_phase<EpiVT0, DenseSched, true>(ring, S, E); }
    }
    SEAM(1);
    if (IN(2)) {
        for (int u = bid; u < 256; u += G) s5_unit(F, u >> 6, u & 63);
        for (int u = bid; u < 516; u += G) { if (u < 512) gla_pre_unit(F, u >> 7, (u >> 2) & 31, u & 3); else gla_meta_unit(F, u - 512); }
    }
    SEAM(2);
    if (IN(3)) { gla_scan(F); }
    SEAM(3);
    if (IN(4)) {
        glu_meta_skinny(F);
        if (G == 256) {
            if (bid >= 128) { for (int k = 0; k < 3; ++k) { const int u = (bid - 128) + 128 * k; gla_out_unit(F, u >> 7, (u >> 2) & 31, u & 3); } }
            else { const int u = 384 + bid; gla_out_unit(F, u >> 7, (u >> 2) & 31, u & 3); }
        } else { for (int u = bid; u < 512; u += G) gla_out_unit(F, u >> 7, (u >> 2) & 31, u & 3); }
        __syncthreads();
        { DenseSched S; S.init(WSP(bf16, WS_Z), 2048, WSP(bf16, WS_WGLUT), 2048, 1024, 32, 4, 0, 0, 0, G, bid);
          EpiGlu E{WSP(bf16, WS_Z), WSP(bf16, WS_MIXED0)};
          pg8::gemm_phase<EpiGlu, DenseSched, false>(ring, S, E); }
    }
    SEAM(4);
    if (IN(5)) {
        out0_meta_skinny(F);
        __syncthreads();
        DenseSched S; S.init(WSP(bf16, WS_MIXED0), 4096, WSP(bf16, WS_WOUT0T), 4096, 2048, 32, 8, 0, 0, 0, G, bid);
        EpiOut E{F.inp(I_X), WSP(float, WS_Y0)};
        pg8::gemm_phase<EpiOut, DenseSched, false>(ring, S, E);
    }
    SEAM(5);
    if (IN(6)) { ln_router_phase(F, 0, TR, 0); }
    SEAM(6);
    if (IN(7)) {
        const int nlist = moe_tables(F, 0, TR, TP, CN, LST);
        MoeSchedGU S; S.lda = 4096; S.ldb = 4096; S.K = 2048; S.TP = TP; S.CNT = CN; S.A = (const char*)WSP(bf16, WS_H1B); S.B = (const char*)WSP(bf16, WS_WGU);
        S.rowidx = WSP(int, WS_ROWIDX); S.LST = LST; S.nlist = nlist; S.nloc = (G - (bid & 7) + 7) >> 3; S.rank = bid >> 3; S.bstride = (size_t)1024 * 2048 * 2;
        EpiMoeGU E{WSP(bf16, WS_HBUF)};
        pg8::gemm_phase<EpiMoeGU, MoeSchedGU, false>(ring, S, E);
    }
    SEAM(7);
    if (IN(8)) {
        const int nlist = moe_tables(F, 0, TR, TP, CN, LST);
        MoeSchedDN S; S.lda = 1024; S.ldb = 1024; S.K = 512; S.TP = TP; S.CNT = CN; S.A = (const char*)WSP(bf16, WS_HBUF); S.B = (const char*)WSP(bf16, WS_WD);
        S.rowidx = nullptr; S.LST = LST; S.nlist = nlist; S.nloc = (G - (bid & 7) + 7) >> 3; S.rank = bid >> 3; S.bstride = (size_t)2048 * 512 * 2;
        EpiMoeDN E{WSP(bf16, WS_YBUF)};
        pg8::gemm_phase<EpiMoeDN, MoeSchedDN, false>(ring, S, E);
    }
    SEAM(8);
    if (IN(9)) { (void)moe_tables(F, 0, TR, TP, CN, LST); combine_ln_phase(F, 0, TR, TP); }
    SEAM(9);
    if (IN(10)) {
        kv1_meta_skinny(F);
        __syncthreads();
        { DenseSched S; S.init(WSP(bf16, WS_H2B), 4096, WSP(bf16, WS_WIN1T), 4096, 2048, 32, 16, 0, 16, 32, G, bid);
          EpiIn1 E{WSP(bf16, WS_PQ), WSP(bf16, WS_KN1), WSP(bf16, WS_GATE1), WSP(f32x2, WS_ROPE)};
          pg8::gemm_phase<EpiIn1, DenseSched, false>(ring, S, E); }
        { DenseSched S; S.init(WSP(bf16, WS_H2B), 4096, WSP(bf16, WS_WIN1T), 4096, 2048, 32, 24, 8, 0, 0, G, bid);
          EpiIn1T E{WSP(bf16, WS_KNT1), WSP(bf16, WS_VS), WSP(f32x2, WS_ROPE)};
          pg8::gemm_phase<EpiIn1T, DenseSched, true>(ring, S, E); }
    }
    SEAM(10);
    if (IN(11)) {
        BatchSched S; S.lda = 1024; S.ldb = 4096; S.K = 256; S.A = (const char*)WSP(bf16, WS_VS); S.B = (const char*)WSP(bf16, WS_KNT1);
        S.sA_g = (size_t)512 * 512 * 2; S.sA_j = (size_t)256 * 512 * 2; S.sB_b = (size_t)2048 * 2048 * 2; S.sB_h = (size_t)256 * 2048 * 2; S.sB_sc = 512; S.sB_g = 0; S.sB_j = 0;
        S.per = 2; S.n = 512; S.G = G; S.c = bid;
        EpiRetA E{WSP(bf16, WS_VS)};
        pg8::gemm_phase<EpiRetA, BatchSched, false>(ring, S, E);
    }
    SEAM(11);
    if (IN(12)) { ret_scan(F); }
    SEAM(12);
    if (IN(13)) {
        BatchSched S; S.lda = 1024; S.ldb = 4096; S.K = 256; S.A = (const char*)(WSP(bf16, WS_PQ) + 256); S.B = (const char*)WSP(bf16, WS_KN1);
        S.sA_g = (size_t)256 * 512 * 2; S.sA_j = 0; S.sB_b = (size_t)2048 * 2048 * 2; S.sB_h = 512; S.sB_sc = (size_t)256 * 2048 * 2; S.sB_g = 0; S.sB_j = 0;
        S.per = 1; S.n = 256; S.G = G; S.c = bid;
        EpiRetP E{WSP(bf16, WS_PQ)};
        pg8::gemm_phase<EpiRetP, BatchSched, false>(ring, S, E);
    }
    SEAM(13);
    if (IN(14)) {
        BatchSched S; S.lda = 1024; S.ldb = 1024; S.K = 512; S.A = (const char*)WSP(bf16, WS_PQ); S.B = (const char*)WSP(bf16, WS_VS);
        S.sA_g = (size_t)256 * 512 * 2; S.sA_j = 0; S.sB_b = 0; S.sB_h = 0; S.sB_sc = 0; S.sB_g = (size_t)512 * 512 * 2; S.sB_j = (size_t)256 * 512 * 2;
        S.per = 2; S.n = 512; S.G = G; S.c = bid;
        EpiRetO E{WSP(bf16, WS_O1)};
        pg8::gemm_phase<EpiRetO, BatchSched, false>(ring, S, E);
    }
    SEAM(14);
    if (IN(15)) { ret_norm_phase(F); }
    SEAM(15);
    if (IN(16)) {
        DenseSched S; S.init(WSP(bf16, WS_MIXED1), 8192, WSP(bf16, WS_WOUT1T), 8192, 4096, 32, 8, 0, 0, 0, G, bid);
        EpiOut E{WSP(float, WS_H2F), WSP(float, WS_Y0)};
        pg8::gemm_phase<EpiOut, DenseSched, false>(ring, S, E);
    }
    SEAM(16);
    if (IN(17)) { ln_router_phase(F, 1, TM, 1); }
    SEAM(17);
    if (IN(18)) {
        const int nlist = moe_tables(F, 1, TM, TP, CN, LST);
        MoeSchedGU S; S.lda = 4096; S.ldb = 4096; S.K = 2048; S.TP = TP; S.CNT = CN; S.A = (const char*)WSP(bf16, WS_H1B); S.B = (const char*)(WSP(bf16, WS_WGU) + (size_t)NEX * 1024 * 2048);
        S.rowidx = WSP(int, WS_ROWIDX); S.LST = LST; S.nlist = nlist; S.nloc = (G - (bid & 7) + 7) >> 3; S.rank = bid >> 3; S.bstride = (size_t)1024 * 2048 * 2;
        EpiMoeGU E{WSP(bf16, WS_HBUF)};
        pg8::gemm_phase<EpiMoeGU, MoeSchedGU, false>(ring, S, E);
    }
    SEAM(18);
    if (IN(19)) {
        const int nlist = moe_tables(F, 1, TM, TP, CN, LST);
        MoeSchedDN S; S.lda = 1024; S.ldb = 1024; S.K = 512; S.TP = TP; S.CNT = CN; S.A = (const char*)WSP(bf16, WS_HBUF); S.B = (const char*)(WSP(bf16, WS_WD) + (size_t)NEX * 2048 * 512);
        S.rowidx = nullptr; S.LST = LST; S.nlist = nlist; S.nloc = (G - (bid & 7) + 7) >> 3; S.rank = bid >> 3; S.bstride = (size_t)2048 * 512 * 2;
        EpiMoeDN E{WSP(bf16, WS_YBUF)};
        pg8::gemm_phase<EpiMoeDN, MoeSchedDN, false>(ring, S, E);
    }
    SEAM(19);
    if (IN(20)) { (void)moe_tables(F, 1, TM, TP, CN, LST); combine_ln_phase(F, 1, TM, TP); }
#undef IN
#undef SEAM
}

#ifndef MK_CUTS
#define MK_CUTS 0
#endif
extern "C" void kernel_launch(void* const* d_in, const int* in_sizes, int n_in, void* d_out, int out_size, void* d_ws, size_t ws_size, hipStream_t stream) {
    static int grid = 0;
    if (grid == 0) {
        if (n_in != 31 || ws_size < WS_END) { fprintf(stderr, "kernel_launch: expected 31 inputs and >= %zu bytes of workspace (got %d, %zu)\n", (size_t)WS_END, n_in, ws_size); grid = -1; return; }
        int dev = 0, cus = 0, per_cu = 0;
        if (hipGetDevice(&dev) != hipSuccess || hipDeviceGetAttribute(&cus, hipDeviceAttributeMultiprocessorCount, dev) != hipSuccess) { grid = -1; return; }
        if (hipFuncSetAttribute((const void*)mk_fwd, hipFuncAttributeMaxDynamicSharedMemorySize, LDS_BYTES) != hipSuccess) { fprintf(stderr, "kernel_launch: hipFuncSetAttribute failed\n"); grid = -1; return; }
        if (hipOccupancyMaxActiveBlocksPerMultiprocessor(&per_cu, (const void*)mk_fwd, NTHR, LDS_BYTES) != hipSuccess || per_cu < 1) { fprintf(stderr, "kernel_launch: occupancy query says %d\n", per_cu); }
        (void)hipGetLastError();
        grid = cus;
    }
    if (grid < 0) return;
    (void)hipMemsetAsync((char*)d_ws + WS_CTL, 0, CTL_ZERO_BYTES, stream);
    Args a{};
    for (int i = 0; i < 31; ++i) a.in[i] = (const float*)d_in[i];
    a.out = (float*)d_out; a.ws = (unsigned char*)d_ws; a.pad = 0;
#if defined(PROBE_PHASE)
    { int li = 0;
      a.ph_lo = 0; a.ph_hi = PROBE_PHASE + 1; a.li = li++; hipLaunchKernelGGL(mk_fwd, dim3(grid), dim3(NTHR), LDS_BYTES, stream, a);
      if (PROBE_PHASE == 6 || PROBE_PHASE == 17) (void)hipMemsetAsync((char*)d_ws + WS_CTL + (size_t)CW_CNT * 4, 0, 4096, stream);
      a.ph_lo = PROBE_PHASE; a.ph_hi = PROBE_PHASE + 1; a.li = li++; hipLaunchKernelGGL(mk_fwd, dim3(grid), dim3(NTHR), LDS_BYTES, stream, a);
      if (PROBE_PHASE + 1 < NPHASE) { a.ph_lo = PROBE_PHASE + 1; a.ph_hi = NPHASE; a.li = li++; hipLaunchKernelGGL(mk_fwd, dim3(grid), dim3(NTHR), LDS_BYTES, stream, a); } }
#elif MK_CUTS == 0
    a.ph_lo = 0; a.ph_hi = NPHASE; a.li = 0;
    hipLaunchKernelGGL(mk_fwd, dim3(grid), dim3(NTHR), LDS_BYTES, stream, a);
#else
    for (int p = 0; p < NPHASE; ++p) { a.ph_lo = p; a.ph_hi = p + 1; a.li = 0; hipLaunchKernelGGL(mk_fwd, dim3(grid), dim3(NTHR), LDS_BYTES, stream, a); }
#endif
}
```

```cpp
#include <hip/hip_runtime.h>
#include <cstdio>
#include <cstdint>

#define DI __device__ __forceinline__
#define LAS __attribute__((address_space(3)))
#define GAS __attribute__((address_space(1)))
typedef unsigned short bf16;
typedef short bf16x8 __attribute__((ext_vector_type(8)));
typedef short s16x4 __attribute__((ext_vector_type(4)));
typedef float f32x4 __attribute__((ext_vector_type(4)));
typedef float f32x2 __attribute__((ext_vector_type(2)));
typedef unsigned u32x4 __attribute__((ext_vector_type(4)));
typedef unsigned u32x2 __attribute__((ext_vector_type(2)));
typedef __bf16 bf2_t __attribute__((ext_vector_type(2)));
typedef GAS unsigned gu32;
#define RLX_AGENT __ATOMIC_RELAXED, __HIP_MEMORY_SCOPE_AGENT
#define MFMA16(a, b, c) __builtin_amdgcn_mfma_f32_16x16x32_bf16((a), (b), (c), 0, 0, 0)

DI unsigned pk2(float lo, float hi) { bf2_t v; v.x = (__bf16)lo; v.y = (__bf16)hi; return __builtin_bit_cast(unsigned, v); }
DI bf16 f2bf(float f) { return (bf16)(pk2(f, 0.f) & 0xffffu); }
DI float bf2f(unsigned b) { return __uint_as_float(b << 16); }
DI float bflo(unsigned w) { return __uint_as_float(w << 16); }
DI float bfhi(unsigned w) { return __uint_as_float(w & 0xffff0000u); }
DI u32x4 pk8(f32x4 a, f32x4 b) { u32x4 w; w.x = pk2(a[0], a[1]); w.y = pk2(a[2], a[3]); w.z = pk2(b[0], b[1]); w.w = pk2(b[2], b[3]); return w; }
DI float sigmoidf_(float x) { return 1.0f / (1.0f + __expf(-x)); }
DI float siluf_(float x) { return x / (1.0f + __expf(-x)); }
DI float gelu_tanh(float x) { const float u = 0.7978845608028654f * (x + 0.044715f * x * x * x); const float e = __expf(-2.0f * fabsf(u)); const float t = (1.0f - e) / (1.0f + e); return 0.5f * x * (1.0f + (u < 0.f ? -t : t)); }
DI float wave_sum(float v) {
#pragma unroll
    for (int o = 1; o < 64; o <<= 1) v += __shfl_xor(v, o);
    return v;
}

constexpr int D = 2048, NB = 4, SEQ = 2048, TM = 8192, NMETA = 16, TR = TM + NMETA, TRP = 8448;
constexpr int S5W = 1024, GQK = 512, GWD = 1024, ABC = 4112, GDK = 128, GDV = 256;
constexpr int RQK = 2048, RWD = 4096, RETC = 12288, RDK = 256, RDV = 512, RH = 8;
constexpr int NE = 64, NEX = 65, FF = 512, TOPK = 8;
constexpr float ALPHA = 1.4142135623730951f;
constexpr float LN_EPS = 1e-5f;
constexpr int NWAVES = 8, NTHR = 512;

constexpr size_t MiB = 1u << 20;
constexpr size_t WS_CTL = 0, CTL_ZERO_BYTES = 4 * MiB;
constexpr size_t WS_WIN0T = 4 * MiB;
constexpr size_t WS_WGLUT = 21 * MiB;
constexpr size_t WS_WOUT0T = 23 * MiB;
constexpr size_t WS_WIN1T = 31 * MiB;
constexpr size_t WS_WOUT1T = 79 * MiB;
constexpr size_t WS_RT = 95 * MiB;
constexpr size_t WS_TM = 96 * MiB;
constexpr size_t WS_BKT = 108 * MiB;
constexpr size_t WS_A16 = 112 * MiB;
constexpr size_t WS_ROPE = 113 * MiB;
constexpr size_t WS_WGU = 116 * MiB;
constexpr size_t WS_WD = 636 * MiB;
constexpr size_t WS_XB = 896 * MiB;
constexpr size_t WS_U = 929 * MiB;
constexpr size_t WS_UMETA = 945 * MiB;
constexpr size_t WS_QRAW = 946 * MiB;
constexpr size_t WS_KRAW = 955 * MiB;
constexpr size_t WS_R = 964 * MiB;
constexpr size_t WS_VT0 = 981 * MiB;
constexpr size_t WS_Z = 997 * MiB;
constexpr size_t WS_MIXED0 = 1014 * MiB;
constexpr size_t WS_QS = 1047 * MiB;
constexpr size_t WS_KN = 1056 * MiB;
constexpr size_t WS_ST0 = 1065 * MiB;
constexpr size_t WS_GL = 1097 * MiB;
constexpr size_t WS_PMETA = 1098 * MiB;
constexpr size_t WS_DC0 = 1099 * MiB;
constexpr size_t WS_SMETA0 = 1100 * MiB;
constexpr size_t WS_KVMETA = 1101 * MiB;
constexpr size_t WS_ROUTE = 1102 * MiB;
constexpr size_t WS_ROWIDX = 1103 * MiB;
constexpr size_t WS_Y0 = 1106 * MiB;
constexpr size_t WS_H1F = 1172 * MiB;
constexpr size_t WS_H1B = 1238 * MiB;
constexpr size_t WS_H2F = 1271 * MiB;
constexpr size_t WS_H2B = 1337 * MiB;
constexpr size_t WS_HBUF = 1370 * MiB;
constexpr size_t WS_YBUF = 1459 * MiB;
constexpr size_t WS_END = 1812 * MiB;
constexpr size_t WS_PQ = WS_YBUF;
constexpr size_t WS_KN1 = WS_YBUF + 64 * MiB;
constexpr size_t WS_KNT1 = WS_YBUF + 97 * MiB;
constexpr size_t WS_VS = WS_YBUF + 129 * MiB;
constexpr size_t WS_GATE1 = WS_YBUF + 257 * MiB;
constexpr size_t WS_O1 = WS_XB;
constexpr size_t WS_MIXED1 = WS_VT0;
static_assert(WS_O1 + 64 * MiB <= WS_VT0 && WS_MIXED1 + 64 * MiB <= WS_QS, "layer-1 aliases");
static_assert(WS_GATE1 + 66 * MiB <= WS_END, "gate1");
constexpr int MAXSLOTS = 90368;
constexpr int CW_BAR = 4096;
constexpr int CW_CNT = 65536;
constexpr int XCD_BAR_WORDS_C = 3456;
constexpr int MAX_LAUNCH = 16;
static_assert(CW_BAR + MAX_LAUNCH * XCD_BAR_WORDS_C <= CW_CNT, "ctl map");

constexpr int RING_BYTES = 131072;
constexpr int MISC_OFF = RING_BYTES;
constexpr int LDS_BYTES = 147456;

#define XB_TMO      128
#define XB_XCNT(j)  (256  + 64 * (j))
#define XB_XSUB(j)  (1280 + 64 * (j))
#define XB_XGEN(j)  (2304 + 64 * (j))
#define XB_TOP      3328
#define XB_TOPGEN   3392
#define XCD_BAR_WORDS 3456
#define XB_SPIN_CAP (1u << 18)
DI unsigned xb_ld(unsigned* p)              { return __hip_atomic_load(p, __ATOMIC_RELAXED, __HIP_MEMORY_SCOPE_AGENT); }
DI unsigned xb_add(unsigned* p, unsigned v) { return __hip_atomic_fetch_add(p, v, __ATOMIC_RELAXED, __HIP_MEMORY_SCOPE_AGENT); }
DI unsigned xb_xcc_id() { return (unsigned)__builtin_amdgcn_s_getreg((3 << 11) | 20) & 0xFu; }
#define XB_SPIN(cond, bar) do { unsigned _sp = 0; while (cond) { __builtin_amdgcn_s_sleep(1); \
    if ((++_sp & 255u) == 0u) { if (xb_ld(&(bar)[XB_TMO])) break; if (_sp > XB_SPIN_CAP) { atomicAdd(&(bar)[XB_TMO], 1u); break; } } } } while (0)
struct XcdBarrier { unsigned* bar; unsigned x; volatile LAS unsigned* st; };
DI XcdBarrier xcd_barrier_post(unsigned* bar, volatile LAS unsigned* st) {
    XcdBarrier b; b.bar = bar; b.x = xb_xcc_id(); b.st = st;
    if (threadIdx.x == 0) (void)xb_add(&bar[XB_XCNT(b.x)], 1u);
    return b;
}
DI void xcd_barrier_complete(unsigned* bar, unsigned x, unsigned& nloc, unsigned& nx) {
    const unsigned G = gridDim.x * gridDim.y * gridDim.z;
    unsigned sum, cnt, mine, sp = 0u;
    for (;;) {
        sum = 0u; cnt = 0u; mine = 0u;
#pragma unroll
        for (unsigned j = 0; j < 16; ++j) { const unsigned c = xb_ld(&bar[XB_XCNT(j)]); sum += c; cnt += (c > 0u) ? 1u : 0u; mine = (j == x) ? c : mine; }
        if (sum == G) break;
        __builtin_amdgcn_s_sleep(1);
        if ((++sp & 255u) == 0u) { if (xb_ld(&bar[XB_TMO])) break; if (sp > XB_SPIN_CAP) { atomicAdd(&bar[XB_TMO], 1u); break; } }
    }
    nloc = mine > 0u ? mine : 1u; nx = cnt > 0u ? cnt : 1u;
}
DI void xcd_barrier(const XcdBarrier& b) {
    asm volatile("s_waitcnt vmcnt(0)" ::: "memory");
    __syncthreads();
    if (threadIdx.x == 0) {
        unsigned* bar = b.bar;
        __builtin_amdgcn_s_waitcnt(0);
        unsigned nloc = b.st[0], nx = b.st[1];
        if (nloc == 0u) { xcd_barrier_complete(bar, b.x, nloc, nx); b.st[0] = nloc; b.st[1] = nx; }
        const unsigned old = xb_add(&bar[XB_XSUB(b.x)], 1u);
        const unsigned gen = old / nloc;
        if (old + 1u == (gen + 1u) * nloc) {
            __builtin_amdgcn_fence(__ATOMIC_RELEASE, "agent");
            asm volatile("s_waitcnt vmcnt(0)" ::: "memory");
            const unsigned og = xb_add(&bar[XB_TOP], 1u);
            const unsigned tg = og / nx;
            if (og + 1u == (tg + 1u) * nx) xb_add(&bar[XB_TOPGEN], 1u);
            else XB_SPIN(xb_ld(&bar[XB_TOPGEN]) == tg, bar);
            __builtin_amdgcn_fence(__ATOMIC_ACQUIRE, "agent");
            xb_add(&bar[XB_XGEN(b.x)], 1u);
            asm volatile("s_waitcnt vmcnt(0)" ::: "memory");
        } else {
            XB_SPIN(xb_ld(&bar[XB_XGEN(b.x)]) == gen, bar);
            __builtin_amdgcn_fence(__ATOMIC_ACQUIRE, "agent");
            asm volatile("s_waitcnt vmcnt(0)" ::: "memory");
        }
    }
    __syncthreads();
}
namespace pg8 {
constexpr int BM = 256, BK = 64, HALF = 128, HTB = HALF * BK * 2, STAGE_BYTES = 8 * HTB;
DI int lds_byte(int r, int c) { const int st = (r >> 4) * 2 + (c >> 5), rr = r & 15, cc = c & 31, ob = rr * 64 + cc * 2; return st * 1024 + (ob ^ (((ob >> 9) & 1) << 5)); }
DI void stage_rc(int b, int& R, int& C) { const int st = b / 1024, sb = b % 1024, swz = sb ^ (((sb >> 9) & 1) << 5); R = (st >> 1) * 16 + swz / 64; C = (st & 1) * 32 + (swz % 64) / 2; }
DI int perm32(int rho) { const int n = rho >> 4, i = rho & 15; return 8 * (i >> 2) + 4 * n + (i & 3); }
DI int permrow(int R) { return (R & ~31) + perm32(R & 31); }

struct GUnit { const char* A; const char* B; const int* rows; int r0, c0, aux, nvalid; };

template <class Epi, class Sched, bool TRANS>
DI void gemm_phase(LAS unsigned char* lds, const Sched& S, const Epi& E) {
    const int tid = threadIdx.x, wid = __builtin_amdgcn_readfirstlane(tid >> 6), lane = tid & 63, wr = wid >> 2, wc = wid & 3, fr = lane & 15, fq = lane >> 4;
    const int K = S.K, nt = K / BK;
    const unsigned lda = (unsigned)S.lda, ldb = (unsigned)S.ldb;
    const int R0 = (wid >> 1) * 16 + (lane >> 2), C0 = (wid & 1) * 32 + ((((lane * 16) & 63) ^ (((lane >> 5) & 1) << 5)) >> 1);
    const unsigned voffB0 = (unsigned)(TRANS ? R0 : permrow(R0)) * ldb + (unsigned)C0 * 2u;
    const unsigned voffA0 = (unsigned)(TRANS ? permrow(R0) : R0) * lda + (unsigned)C0 * 2u;
    LAS int* gtab = (LAS int*)(lds + 131072 + 8192);
    const size_t kstep = (size_t)(BK * 2);
    const unsigned ldsw = (unsigned)wid * 1024u;
    const int aoff = lds_byte(wr * 64 + fr, fq * 8), boff = lds_byte(wc * 32 + fr, fq * 8);
#define PG8_SA(b, h) (((b) * 2 + (h)) * HTB)
#define PG8_SB(b, h) ((4 + (b) * 2 + (h)) * HTB)
#define PG8_GLDS(gptr, bufoff, _i) __builtin_amdgcn_global_load_lds((const unsigned*)(gptr), (LAS unsigned*)(lds + (bufoff) + ldsw + (_i) * 8192), 16, 0, 0)
#define PG8_STAGE_B(bufoff, gbase, h) do { _Pragma("unroll") for (int _i = 0; _i < 2; ++_i) PG8_GLDS((const char*)(gbase) + (size_t)((h) * HALF + _i * 64) * ldb + voffB0, bufoff, _i); } while (0)
#define PG8_STAGE_A(bufoff, gbase, h, tb, nv) do { _Pragma("unroll") for (int _i = 0; _i < 2; ++_i) { \
        if constexpr (Sched::GATHER) { const int _r = (h) * HALF + _i * 64 + R0; const int _ix = gtab[(tb) * 256 + (_r < (nv) ? _r : 0)]; \
            PG8_GLDS((const char*)(gbase) + ((unsigned)_ix * lda + (unsigned)C0 * 2u), bufoff, _i); } \
        else PG8_GLDS((const char*)(gbase) + (size_t)((h) * HALF + _i * 64) * lda + voffA0, bufoff, _i); } } while (0)
#define PG8_LDA(dst, b, h) do { _Pragma("unroll") for (int m = 0; m < 4; ++m) _Pragma("unroll") for (int k = 0; k < 2; ++k) dst[m][k] = *(const LAS bf16x8*)(lds + PG8_SA(b, h) + aoff + m * 2048 + k * 1024); } while (0)
#define PG8_LDB(dst, b, h) do { _Pragma("unroll") for (int n = 0; n < 2; ++n) _Pragma("unroll") for (int k = 0; k < 2; ++k) dst[n][k] = *(const LAS bf16x8*)(lds + PG8_SB(b, h) + boff + n * 2048 + k * 1024); } while (0)
#define PG8_MMA(ai, bj, At, Bt) do { __builtin_amdgcn_s_setprio(1); _Pragma("unroll") for (int m = 0; m < 4; ++m) _Pragma("unroll") for (int n = 0; n < 2; ++n) _Pragma("unroll") for (int k = 0; k < 2; ++k) \
        acc[ai][bj][m][n] = TRANS ? __builtin_amdgcn_mfma_f32_16x16x32_bf16(At[m][k], Bt[n][k], acc[ai][bj][m][n], 0, 0, 0) \
                                  : __builtin_amdgcn_mfma_f32_16x16x32_bf16(Bt[n][k], At[m][k], acc[ai][bj][m][n], 0, 0, 0); __builtin_amdgcn_s_setprio(0); } while (0)
#define PG8_WAIT_V(n) asm volatile("s_waitcnt vmcnt(" #n ")" ::: "memory")
#define PG8_WAIT_L(n) asm volatile("s_waitcnt lgkmcnt(" #n ")" ::: "memory")
#define PG8_BAR __builtin_amdgcn_s_barrier()
#define PG8_SCHED __builtin_amdgcn_sched_barrier(0)
    GUnit cur, nxt; int ui = 0;
    if (!S.next(0, cur)) return;
    if constexpr (Sched::GATHER) { if (tid < 256) gtab[tid] = cur.rows[tid < cur.nvalid ? tid : 0]; asm volatile("s_waitcnt vmcnt(0) lgkmcnt(0)" ::: "memory"); PG8_BAR; }
    f32x4 acc[2][2][4][2];
#pragma unroll
    for (int a = 0; a < 2; ++a)
#pragma unroll
        for (int b = 0; b < 2; ++b)
#pragma unroll
            for (int m = 0; m < 4; ++m)
#pragma unroll
                for (int n = 0; n < 2; ++n) acc[a][b][m][n] = (f32x4){0.f, 0.f, 0.f, 0.f};
    bf16x8 At[4][2], B0[2][2], B1[2][2];
    const char* cA = cur.A; const char* cB = cur.B;
    PG8_STAGE_B(PG8_SB(0, 0), cB, 0); PG8_STAGE_B(PG8_SB(0, 1), cB, 1); PG8_STAGE_A(PG8_SA(0, 0), cA, 0, 0, cur.nvalid); PG8_STAGE_A(PG8_SA(0, 1), cA, 1, 0, cur.nvalid);
    if (wr == 1) PG8_BAR;
    PG8_WAIT_V(2); PG8_BAR;
    PG8_STAGE_B(PG8_SB(1, 0), cB + kstep, 0); PG8_STAGE_A(PG8_SA(1, 0), cA + kstep, 0, 0, cur.nvalid); PG8_STAGE_B(PG8_SB(1, 1), cB + kstep, 1);
    PG8_WAIT_V(6); PG8_BAR;
    for (;;) {
        const bool has_next = S.next(ui + 1, nxt);
        const int tb = ui & 1, ntb = has_next ? (tb ^ 1) : tb, cnv = cur.nvalid, nnv = has_next ? nxt.nvalid : cur.nvalid;
        if constexpr (Sched::GATHER) {
            if (has_next && tid < 256) __builtin_amdgcn_global_load_lds((const unsigned*)(nxt.rows + tid), (LAS unsigned*)(gtab + ntb * 256 + wid * 64), 4, 0, 0); }
        const char* nA = has_next ? nxt.A : cA; const char* nB = has_next ? nxt.B : cB;
        for (int t = 0; t < nt; t += 2) {
            const bool last = (t == nt - 2);
            const char* a1 = cA + (size_t)(t + 1) * kstep;
            const char* a2 = last ? nA : cA + (size_t)(t + 2) * kstep; const char* b2 = last ? nB : cB + (size_t)(t + 2) * kstep;
            const char* a3 = a2 + kstep; const char* b3 = b2 + kstep;
            PG8_LDB(B0, 0, 0); PG8_LDB(B1, 0, 1); PG8_SCHED; PG8_LDA(At, 0, 0); PG8_STAGE_A(PG8_SA(1, 1), a1, 1, tb, cnv);
            PG8_WAIT_V(8); PG8_WAIT_L(0); PG8_BAR; PG8_MMA(0, 0, At, B0); PG8_MMA(0, 1, At, B1); PG8_BAR; PG8_SCHED;
            PG8_LDA(At, 0, 1); PG8_STAGE_B(PG8_SB(0, 0), b2, 0); PG8_STAGE_B(PG8_SB(0, 1), b2, 1);
            if (Sched::GATHER && last) { PG8_STAGE_A(PG8_SA(0, 0), a2, 0, ntb, nnv); } else { PG8_STAGE_A(PG8_SA(0, 0), a2, 0, tb, cnv); }
            PG8_WAIT_V(8); PG8_WAIT_L(0); PG8_BAR; PG8_MMA(1, 0, At, B0); PG8_MMA(1, 1, At, B1); PG8_BAR; PG8_SCHED;
            PG8_LDB(B0, 1, 0); PG8_LDB(B1, 1, 1); PG8_SCHED; PG8_LDA(At, 1, 0);
            if (Sched::GATHER && last) { PG8_STAGE_A(PG8_SA(0, 1), a2, 1, ntb, nnv); } else { PG8_STAGE_A(PG8_SA(0, 1), a2, 1, tb, cnv); }
            PG8_WAIT_V(8); PG8_WAIT_L(0); PG8_BAR; PG8_MMA(0, 0, At, B0); PG8_MMA(0, 1, At, B1); PG8_BAR; PG8_SCHED;
            PG8_LDA(At, 1, 1); PG8_STAGE_B(PG8_SB(1, 0), b3, 0); PG8_STAGE_B(PG8_SB(1, 1), b3, 1);
            if (Sched::GATHER && last) { PG8_STAGE_A(PG8_SA(1, 0), a3, 0, ntb, nnv); } else { PG8_STAGE_A(PG8_SA(1, 0), a3, 0, tb, cnv); }
            PG8_WAIT_V(8); PG8_WAIT_L(0); PG8_BAR; PG8_MMA(1, 0, At, B0); PG8_MMA(1, 1, At, B1); PG8_BAR; PG8_SCHED;
        }
        if (wr == 0) PG8_BAR;
        E(acc, cur, wr, wc, fr, fq);
        if (!has_next) break;
#pragma unroll
        for (int a = 0; a < 2; ++a)
#pragma unroll
            for (int b = 0; b < 2; ++b)
#pragma unroll
                for (int m = 0; m < 4; ++m)
#pragma unroll
                    for (int n = 0; n < 2; ++n) acc[a][b][m][n] = (f32x4){0.f, 0.f, 0.f, 0.f};
        cur = nxt; cA = nA; cB = nB; ++ui;
        if (wr == 1) PG8_BAR;
    }
    PG8_WAIT_V(0);
    PG8_BAR;
#undef PG8_SA
#undef PG8_SB
#undef PG8_GLDS
#undef PG8_STAGE_A
#undef PG8_STAGE_B
#undef PG8_LDA
#undef PG8_LDB
#undef PG8_MMA
#undef PG8_WAIT_V
#undef PG8_WAIT_L
#undef PG8_BAR
#undef PG8_SCHED
}
}
using pg8::GUnit;
struct DenseSched {
    static constexpr bool GATHER = false;
    int lda, ldb, K;
    const char* A; const char* B;
    int nM, nN, G, c, nN1, ct0, ct1;
    DI void init(const void* A_, int lda_, const void* B_, int ldb_, int K_, int nM_, int nN1_, int ct0_, int nN2_, int ct1_, int G_, int c_) {
        A = (const char*)A_; B = (const char*)B_; lda = lda_; ldb = ldb_; K = K_; nM = nM_; nN1 = nN1_; ct0 = ct0_; ct1 = ct1_; nN = nN1_ + nN2_; G = G_; c = c_; }
    DI bool next(int i, GUnit& u) const {
        const int nwg = nM * nN; const long L = (long)i * G + c; if (L >= nwg) return false;
        int wgid = (int)L; { const int q = nwg / 8, r = nwg % 8, xcd = wgid % 8, off = wgid / 8; wgid = (xcd < r ? xcd * (q + 1) : r * (q + 1) + (xcd - r) * q) + off; }
        const int nig = 8 * nN, gid = wgid / nig, fm = gid * 8, gsz = (nM - fm) < 8 ? (nM - fm) : 8;
        const int pm = fm + ((wgid % nig) % gsz), pn = (wgid % nig) / gsz;
        const int ct = pn < nN1 ? ct0 + pn : ct1 + (pn - nN1);
        u.A = A + (size_t)pm * 256 * (size_t)lda; u.B = B + (size_t)ct * 256 * (size_t)ldb; u.rows = nullptr; u.r0 = pm * 256; u.c0 = ct * 256; u.aux = 0; u.nvalid = 256; return true;
    }
};
struct BatchSched {
    static constexpr bool GATHER = false;
    int lda, ldb, K;
    const char* A; const char* B;
    size_t sA_g, sA_j, sB_b, sB_h, sB_sc, sB_g, sB_j;
    int per, n, G, c;
    DI bool next(int i, GUnit& u) const {
        const long L = (long)i * G + c; if (L >= n) return false;
        const int g = (int)L / per, j = (int)L % per, b = g >> 6, h = (g >> 3) & 7, sc = g & 7;
        u.A = A + g * sA_g + j * sA_j; u.B = B + b * sB_b + h * sB_h + sc * sB_sc + g * sB_g + j * sB_j; u.rows = nullptr; u.r0 = j * 256; u.c0 = 0; u.aux = g; u.nvalid = 256; return true;
    }
};
template <int NCT, bool DOWN> struct MoeSchedT {
    static constexpr bool GATHER = !DOWN;
    int lda, ldb, K;
    const volatile LAS int* TP; const volatile LAS int* CNT; const volatile LAS int* LST;
    const char* A; const char* B; const int* rowidx;
    int nlist, nloc, rank;
    size_t bstride;
    DI bool next(int i, GUnit& u) const {
        const int pos = i * nloc + rank; if (pos >= nlist * NCT) return false;
        const int ent = __builtin_amdgcn_readfirstlane(LST[pos / NCT]), ct = pos % NCT, e = ent >> 16, rt = ent & 0xffff, j = rt - __builtin_amdgcn_readfirstlane(TP[e]);
        u.r0 = rt * 256; u.aux = ct; u.c0 = ct * 256;
        if (DOWN) { u.A = A + (size_t)rt * 256 * (size_t)lda; u.rows = nullptr; u.nvalid = 256; }
        else { u.A = A; u.rows = rowidx + (size_t)e * TRP + j * 256; const int rem = __builtin_amdgcn_readfirstlane(CNT[e]) - j * 256; u.nvalid = rem < 256 ? rem : 256; }
        u.B = B + (size_t)e * bstride + (size_t)ct * 256 * (size_t)ldb;
        return true;
    }
};
typedef MoeSchedT<4, false> MoeSchedGU;
typedef MoeSchedT<8, true> MoeSchedDN;

#define EPI_ARGS const f32x4 (&acc)[2][2][4][2], const GUnit& u, int wr, int wc, int fr, int fq
struct EpiIn0 {
    bf16 *U, *Q, *Kr, *R;
    DI void operator()(EPI_ARGS) const {
        const int c0 = u.c0;
#pragma unroll
        for (int ai = 0; ai < 2; ++ai)
#pragma unroll
            for (int m = 0; m < 4; ++m) {
                const int r = u.r0 + ai * 128 + wr * 64 + m * 16 + fr;
#pragma unroll
                for (int bj = 0; bj < 2; ++bj) {
                    const int c = c0 + bj * 128 + wc * 32 + fq * 8;
                    f32x4 v0 = acc[ai][bj][m][0], v1 = acc[ai][bj][m][1];
                    if (c0 < 1024) { const int b = r >> 11, s = r & 2047, g = c >> 4, ch = c & 15;
                        *(u32x4*)(U + (((size_t)(b * 64 + g) * 2048 + s) * 16 + ch)) = pk8(v0, v1); }
                    else if (c0 < 1536) { const float sc = 0.08838834764831845f; *(u32x4*)(Q + (size_t)r * 512 + (c - 1024)) = pk8(v0 * sc, v1 * sc); }
                    else if (c0 < 2048) { *(u32x4*)(Kr + (size_t)r * 512 + (c - 1536)) = pk8(v0, v1); }
                    else { f32x4 a, b2;
#pragma unroll
                        for (int i = 0; i < 4; ++i) { a[i] = siluf_(v0[i]); b2[i] = siluf_(v1[i]); }
                        *(u32x4*)(R + (size_t)r * 1024 + (c - 3072)) = pk8(a, b2); }
                }
            }
    }
};
struct EpiVT0 {
    bf16* VT;
    DI void operator()(EPI_ARGS) const {
#pragma unroll
        for (int ai = 0; ai < 2; ++ai)
#pragma unroll
            for (int mp = 0; mp < 2; ++mp) {
                const int r = u.r0 + ai * 128 + wr * 64 + mp * 32 + fq * 8, b = r >> 11, s = r & 2047;
#pragma unroll
                for (int bj = 0; bj < 2; ++bj)
#pragma unroll
                    for (int n = 0; n < 2; ++n) {
                        const int c = u.c0 - 2048 + bj * 128 + wc * 32 + n * 16 + fr;
                        *(u32x4*)(VT + ((size_t)(b * 1024 + c) * 2048 + s)) = pk8(acc[ai][bj][2 * mp][n], acc[ai][bj][2 * mp + 1][n]);
                    }
            }
    }
};
struct EpiGlu {
    const bf16* Z; bf16* MX;
    DI void operator()(EPI_ARGS) const {
#pragma unroll
        for (int ai = 0; ai < 2; ++ai)
#pragma unroll
            for (int m = 0; m < 4; ++m) {
                const int r = u.r0 + ai * 128 + wr * 64 + m * 16 + fr;
#pragma unroll
                for (int bj = 0; bj < 2; ++bj) {
                    const int c = u.c0 + bj * 128 + wc * 32 + fq * 8;
                    const u32x4 z = *(const u32x4*)(Z + (size_t)r * 1024 + c);
                    f32x4 v0 = acc[ai][bj][m][0], v1 = acc[ai][bj][m][1], o0, o1;
                    o0[0] = bflo(z.x) * sigmoidf_(v0[0]); o0[1] = bfhi(z.x) * sigmoidf_(v0[1]); o0[2] = bflo(z.y) * sigmoidf_(v0[2]); o0[3] = bfhi(z.y) * sigmoidf_(v0[3]);
                    o1[0] = bflo(z.z) * sigmoidf_(v1[0]); o1[1] = bfhi(z.z) * sigmoidf_(v1[1]); o1[2] = bflo(z.w) * sigmoidf_(v1[2]); o1[3] = bfhi(z.w) * sigmoidf_(v1[3]);
                    *(u32x4*)(MX + (size_t)r * 2048 + c) = pk8(o0, o1);
                }
            }
    }
};
struct EpiOut {
    const float* resid; float* Y;
    DI void operator()(EPI_ARGS) const {
#pragma unroll
        for (int ai = 0; ai < 2; ++ai)
#pragma unroll
            for (int m = 0; m < 4; ++m) {
                const int r = u.r0 + ai * 128 + wr * 64 + m * 16 + fr;
#pragma unroll
                for (int bj = 0; bj < 2; ++bj) {
                    const size_t o = (size_t)r * 2048 + u.c0 + bj * 128 + wc * 32 + fq * 8;
                    const f32x4 x0 = *(const f32x4*)(resid + o), x1 = *(const f32x4*)(resid + o + 4);
                    *(f32x4*)(Y + o) = acc[ai][bj][m][0] + ALPHA * x0; *(f32x4*)(Y + o + 4) = acc[ai][bj][m][1] + ALPHA * x1;
                }
            }
    }
};
struct EpiMoeGU {
    bf16* H;
    DI void operator()(EPI_ARGS) const {
#pragma unroll
        for (int ai = 0; ai < 2; ++ai)
#pragma unroll
            for (int m = 0; m < 4; ++m) {
                const int r = u.r0 + ai * 128 + wr * 64 + m * 16 + fr;
                f32x4 o0, o1;
#pragma unroll
                for (int i = 0; i < 4; ++i) { o0[i] = siluf_(acc[ai][0][m][0][i]) * acc[ai][1][m][0][i]; o1[i] = siluf_(acc[ai][0][m][1][i]) * acc[ai][1][m][1][i]; }
                *(u32x4*)(H + (size_t)r * 512 + u.aux * 128 + wc * 32 + fq * 8) = pk8(o0, o1);
            }
    }
};
struct EpiMoeDN {
    bf16* Y;
    DI void operator()(EPI_ARGS) const {
#pragma unroll
        for (int ai = 0; ai < 2; ++ai)
#pragma unroll
            for (int m = 0; m < 4; ++m) {
                const int r = u.r0 + ai * 128 + wr * 64 + m * 16 + fr;
#pragma unroll
                for (int bj = 0; bj < 2; ++bj)
                    *(u32x4*)(Y + (size_t)r * 2048 + u.c0 + bj * 128 + wc * 32 + fq * 8) = pk8(acc[ai][bj][m][0], acc[ai][bj][m][1]);
            }
    }
};
DI float lg2gamma(int h) { return __log2f(1.0f - exp2f((float)(-5 - h))); }
struct EpiIn1 {
    bf16 *PQ, *KN, *GT; const f32x2* rope;
    DI void operator()(EPI_ARGS) const {
        const int c0 = u.c0;
        if (c0 >= 8192) {
#pragma unroll
            for (int ai = 0; ai < 2; ++ai)
#pragma unroll
                for (int m = 0; m < 4; ++m) {
                    const int r = u.r0 + ai * 128 + wr * 64 + m * 16 + fr;
#pragma unroll
                    for (int bj = 0; bj < 2; ++bj) { f32x4 a, b2;
#pragma unroll
                        for (int i = 0; i < 4; ++i) { a[i] = siluf_(acc[ai][bj][m][0][i]); b2[i] = siluf_(acc[ai][bj][m][1][i]); }
                        *(u32x4*)(GT + (size_t)r * 4096 + (c0 - 8192) + bj * 128 + wc * 32 + fq * 8) = pk8(a, b2); }
                }
            return;
        }
        const bool isq = c0 < 2048; const int h = (isq ? c0 : c0 - 2048) >> 8; const float l2g = lg2gamma(h);
#pragma unroll
        for (int ai = 0; ai < 2; ++ai)
#pragma unroll
            for (int m = 0; m < 4; ++m) {
                const int r = u.r0 + ai * 128 + wr * 64 + m * 16 + fr, b = r >> 11, s = r & 2047, il = s & 255, sc = s >> 8;
                const int j0 = wc * 32 + fq * 8;
                const f32x4* rp = (const f32x4*)(rope + (size_t)(16 + s) * 128 + j0);
                const float dec = isq ? exp2f((float)(il + 1) * l2g) : 0.0625f * exp2f(-(float)(il + 1) * l2g);
                f32x4 o1a, o1b, o2a, o2b;
#pragma unroll
                for (int n = 0; n < 2; ++n) {
                    const f32x4 cs0 = rp[2 * n], cs1 = rp[2 * n + 1];
                    const f32x4 t1 = acc[ai][0][m][n], t2 = acc[ai][1][m][n]; f32x4 p, q2;
                    p[0] = t1[0] * cs0[0] - t2[0] * cs0[1]; q2[0] = t1[0] * cs0[1] + t2[0] * cs0[0];
                    p[1] = t1[1] * cs0[2] - t2[1] * cs0[3]; q2[1] = t1[1] * cs0[3] + t2[1] * cs0[2];
                    p[2] = t1[2] * cs1[0] - t2[2] * cs1[1]; q2[2] = t1[2] * cs1[1] + t2[2] * cs1[0];
                    p[3] = t1[3] * cs1[2] - t2[3] * cs1[3]; q2[3] = t1[3] * cs1[3] + t2[3] * cs1[2];
                    if (n == 0) { o1a = p * dec; o2a = q2 * dec; } else { o1b = p * dec; o2b = q2 * dec; }
                }
                if (isq) { bf16* d = PQ + ((size_t)((b * 8 + h) * 8 + sc) * 256 + il) * 512 + 256 + j0; *(u32x4*)d = pk8(o1a, o1b); *(u32x4*)(d + 128) = pk8(o2a, o2b); }
                else { bf16* d = KN + (size_t)r * 2048 + h * 256 + j0; *(u32x4*)d = pk8(o1a, o1b); *(u32x4*)(d + 128) = pk8(o2a, o2b); }
            }
    }
};
struct EpiIn1T {
    bf16 *KNT, *VS; const f32x2* rope;
    DI void operator()(EPI_ARGS) const {
        const int c0 = u.c0;
        if (c0 >= 4096) {
#pragma unroll
            for (int ai = 0; ai < 2; ++ai)
#pragma unroll
                for (int mp = 0; mp < 2; ++mp) {
                    const int r = u.r0 + ai * 128 + wr * 64 + mp * 32 + fq * 8, b = r >> 11, s = r & 2047, il = s & 255, sc = s >> 8;
#pragma unroll
                    for (int bj = 0; bj < 2; ++bj)
#pragma unroll
                        for (int n = 0; n < 2; ++n) {
                            const int f = c0 - 4096 + bj * 128 + wc * 32 + n * 16 + fr, h = f >> 9, dv = f & 511;
                            *(u32x4*)(VS + ((size_t)((b * 8 + h) * 8 + sc) * 512 + dv) * 512 + il) = pk8(acc[ai][bj][2 * mp][n], acc[ai][bj][2 * mp + 1][n]);
                        }
                }
            return;
        }
        const int h = (c0 - 2048) >> 8; const float l2g = lg2gamma(h);
#pragma unroll
        for (int ai = 0; ai < 2; ++ai)
#pragma unroll
            for (int mp = 0; mp < 2; ++mp) {
                const int r = u.r0 + ai * 128 + wr * 64 + mp * 32 + fq * 8, b = r >> 11, s = r & 2047, il = s & 255;
#pragma unroll
                for (int n = 0; n < 2; ++n) {
                    const int j = wc * 32 + n * 16 + fr;
                    f32x4 o1a, o1b, o2a, o2b;
#pragma unroll
                    for (int t = 0; t < 8; ++t) {
                        const f32x2 cs = rope[(size_t)(16 + s + t) * 128 + j];
                        const float dec = 0.0625f * exp2f(-(float)(il + t + 1) * l2g);
                        const float t1 = acc[ai][0][2 * mp + (t >> 2)][n][t & 3], t2 = acc[ai][1][2 * mp + (t >> 2)][n][t & 3];
                        const float p = (t1 * cs.x - t2 * cs.y) * dec, q2 = (t1 * cs.y + t2 * cs.x) * dec;
                        if (t < 4) { o1a[t & 3] = p; o2a[t & 3] = q2; } else { o1b[t & 3] = p; o2b[t & 3] = q2; }
                    }
                    bf16* d = KNT + ((size_t)(b * 2048 + h * 256 + j) * 2048 + s);
                    *(u32x4*)d = pk8(o1a, o1b); *(u32x4*)(d + (size_t)128 * 2048) = pk8(o2a, o2b);
                }
            }
    }
};
struct EpiRetA {
    bf16* VS;
    DI void operator()(EPI_ARGS) const {
#pragma unroll
        for (int ai = 0; ai < 2; ++ai)
#pragma unroll
            for (int m = 0; m < 4; ++m) {
                const int r = u.r0 + ai * 128 + wr * 64 + m * 16 + fr;
#pragma unroll
                for (int bj = 0; bj < 2; ++bj)
                    *(u32x4*)(VS + ((size_t)u.aux * 512 + r) * 512 + 256 + bj * 128 + wc * 32 + fq * 8) = pk8(acc[ai][bj][m][0], acc[ai][bj][m][1]);
            }
    }
};
struct EpiRetP {
    bf16* PQ;
    DI void operator()(EPI_ARGS) const {
        asm volatile("" : "+v"(fr));
#pragma unroll
        for (int ai = 0; ai < 2; ++ai)
#pragma unroll
            for (int m = 0; m < 4; ++m) {
                const int r = ai * 128 + wr * 64 + m * 16 + fr;
#pragma unroll
                for (int bj = 0; bj < 2; ++bj) {
                    const int c = bj * 128 + wc * 32 + fq * 8; f32x4 a = acc[ai][bj][m][0], b2 = acc[ai][bj][m][1];
#pragma unroll
                    for (int i = 0; i < 4; ++i) {
                        a[i] = __uint_as_float(__float_as_uint(a[i]) & ~(unsigned)((r - c - i) >> 31)); b2[i] = __uint_as_float(__float_as_uint(b2[i]) & ~(unsigned)((r - c - 4 - i) >> 31)); }
                    *(u32x4*)(PQ + ((size_t)u.aux * 256 + r) * 512 + c) = pk8(a, b2);
                }
            }
    }
};
struct EpiRetO {
    bf16* O;
    DI void operator()(EPI_ARGS) const {
        const int g = u.aux, bh = g >> 3, sc = g & 7, b = bh >> 3, h = bh & 7;
#pragma unroll
        for (int ai = 0; ai < 2; ++ai)
#pragma unroll
            for (int m = 0; m < 4; ++m) {
                const int r = b * 2048 + sc * 256 + ai * 128 + wr * 64 + m * 16 + fr;
#pragma unroll
                for (int bj = 0; bj < 2; ++bj)
                    *(u32x4*)(O + (size_t)r * 4096 + h * 512 + u.r0 + bj * 128 + wc * 32 + fq * 8) = pk8(acc[ai][bj][m][0], acc[ai][bj][m][1]);
            }
    }
};
struct Frame {
    LAS unsigned char* lds;
    int tid, lane, wave, G, bid;
    unsigned char* ws;
    float* out;
    DI const float* inp(int i) const { const volatile LAS unsigned* t = (const volatile LAS unsigned*)(lds + 131072 + 2048);
        const unsigned lo = __builtin_amdgcn_readfirstlane(t[2 * i]), hi = __builtin_amdgcn_readfirstlane(t[2 * i + 1]); return (const float*)(((unsigned long long)hi << 32) | lo); }
};
#define WSP(T, off) ((T*)(F.ws + (off)))
#define LDS_WAIT() asm volatile("s_waitcnt lgkmcnt(0)" ::: "memory")
#define VM_WAIT() asm volatile("s_waitcnt vmcnt(0)" ::: "memory")
enum { I_X = 0, I_META, I_ABWIN, I_LOGDT, I_LRE, I_LIM, I_BRE, I_BIM, I_CRE, I_CIM, I_S5D, I_WGLU, I_GW2, I_GBG, I_GNG, I_ABWOUT, I_RWIN, I_RNG, I_RWOUT,
       I_LN1G, I_LN1B, I_LN2G, I_LN2B, I_ROUTER, I_MBIAS, I_MWG, I_MWU, I_MWD, I_SWG, I_SWU, I_SWD };

DI void p0_transpose_item(const float* W, int ldw, bf16* WT, int K, int k0, int n0, int drow0, LAS unsigned* T, int lane) {
    const int nq = lane & 15, kr = lane >> 4;
    const float* src = W + (size_t)(k0 + 2 * kr) * ldw + n0 + 4 * nq;
    f32x4 va[8], vb[8];
#pragma unroll
    for (int p = 0; p < 8; ++p) { va[p] = *(const f32x4*)(src + (size_t)(8 * p) * ldw); vb[p] = *(const f32x4*)(src + (size_t)(8 * p + 1) * ldw); }
#pragma unroll
    for (int p = 0; p < 8; ++p)
#pragma unroll
        for (int i = 0; i < 4; ++i) T[(4 * nq + i) * 33 + 4 * p + kr] = pk2(va[p][i], vb[p][i]);
    LDS_WAIT(); asm volatile("" ::: "memory");
    const int rr = lane >> 3, c = lane & 7;
#pragma unroll
    for (int j = 0; j < 8; ++j) { const int n = 8 * j + rr; const LAS unsigned* t = T + n * 33 + 4 * c;
        u32x4 o; o.x = t[0]; o.y = t[1]; o.z = t[2]; o.w = t[3];
        *(u32x4*)(WT + (size_t)(drow0 + n) * K + k0 + 8 * c) = o; }
    LDS_WAIT(); asm volatile("" ::: "memory");
}
DI void p0_dense_item(Frame& F, int it, LAS unsigned* scr) {
    constexpr int C0 = 32 * 64, C1 = 16 * 16, C2 = 32 * 32, C3 = 32 * 192;
    const float* W; int ldw, K, nblk; bf16* WT;
    if (it < C0) { W = F.inp(I_ABWIN); ldw = ABC; K = 2048; nblk = 64; WT = WSP(bf16, WS_WIN0T); }
    else if ((it -= C0) < C1) { W = F.inp(I_WGLU); ldw = 1024; K = 1024; nblk = 16; WT = WSP(bf16, WS_WGLUT); }
    else if ((it -= C1) < C2) { W = F.inp(I_ABWOUT); ldw = 2048; K = 2048; nblk = 32; WT = WSP(bf16, WS_WOUT0T); }
    else if ((it -= C2) < C3) { W = F.inp(I_RWIN); ldw = RETC; K = 2048; nblk = 192; WT = WSP(bf16, WS_WIN1T); }
    else { it -= C3; W = F.inp(I_RWOUT); ldw = 2048; K = 4096; nblk = 32; WT = WSP(bf16, WS_WOUT1T); }
    const int kb = it / nblk, nb = it % nblk;
    p0_transpose_item(W, ldw, WT, K, 64 * kb, 64 * nb, 64 * nb, scr, F.lane);
}
constexpr int P0_DENSE_ITEMS = 32 * 64 + 16 * 16 + 32 * 32 + 32 * 192 + 64 * 32;
constexpr int P0_MOE_ITEMS = 2 * NEX * 3 * 256;
DI void p0_moe_item(Frame& F, int it, LAS unsigned* scr) {
    const int l = it / (NEX * 768); int rem = it % (NEX * 768); const int e = rem / 768; rem %= 768; const int mat = rem / 256, k = rem % 256;
    if (mat < 2) {
        const float* W = (e < NE) ? F.inp(mat == 0 ? I_MWG : I_MWU) + (size_t)(l * NE + e) * 2048 * 512 : F.inp(mat == 0 ? I_SWG : I_SWU) + (size_t)l * 2048 * 512;
        bf16* WT = WSP(bf16, WS_WGU) + (size_t)(l * NEX + e) * 1024 * 2048;
        const int kb = k / 8, nb = k % 8, n0 = 64 * nb;
        p0_transpose_item(W, 512, WT, 2048, 64 * kb, n0, (n0 >> 7) * 256 + mat * 128 + (n0 & 127), scr, F.lane);
    } else {
        const float* W = (e < NE) ? F.inp(I_MWD) + (size_t)(l * NE + e) * 512 * 2048 : F.inp(I_SWD) + (size_t)l * 512 * 2048;
        bf16* WT = WSP(bf16, WS_WD) + (size_t)(l * NEX + e) * 2048 * 512;
        const int kb = k / 32, nb = k % 32;
        p0_transpose_item(W, 2048, WT, 512, 64 * kb, 64 * nb, 64 * nb, scr, F.lane);
    }
}
DI void p0_s5_group(Frame& F, int g) {
    LAS f32x2* POW = (LAS f32x2*)(F.lds);
    LAS f32x2* BB = (LAS f32x2*)(F.lds + 9216);
    LAS f32x2* CC = (LAS f32x2*)(F.lds + 9216 + 8192);
    LAS float* KD = (LAS float*)(F.lds + 9216 + 16384);
    LAS f32x2* ZS = (LAS f32x2*)(F.lds + 9216 + 32768);
    const int tid = F.tid;
    if (tid < 64) {
        const int p = tid; const float dt = expf(F.inp(I_LOGDT)[g]); const float lr = F.inp(I_LRE)[g * 64 + p], li = F.inp(I_LIM)[g * 64 + p];
        for (int k = 0; k <= 16; ++k) { const float mag = expf(lr * dt * (float)k); float sn, cs; sincosf(li * dt * (float)k, &sn, &cs); POW[k * 64 + p] = (f32x2){mag * cs, mag * sn}; }
        const f32x2 ab = POW[64 + p]; const float nr = ab.x - 1.0f, ni = ab.y, den = lr * lr + li * li;
        ZS[p] = (f32x2){(nr * lr + ni * li) / den, (ni * lr - nr * li) / den};
        const f32x2 a16 = POW[16 * 64 + p]; float* o = WSP(float, WS_A16) + (size_t)(g * 64 + p) * 2; o[0] = a16.x; o[1] = a16.y;
    }
    __syncthreads();
    for (int e = tid; e < 1024; e += NTHR) {
        const int p = e >> 4, c = e & 15; const f32x2 z = ZS[p]; const float br = F.inp(I_BRE)[(size_t)(g * 64 + p) * 16 + c], bi = F.inp(I_BIM)[(size_t)(g * 64 + p) * 16 + c];
        BB[p * 16 + c] = (f32x2){z.x * br - z.y * bi, z.x * bi + z.y * br};
        const int c2 = e >> 6, p2 = e & 63;
        CC[c2 * 64 + p2] = (f32x2){F.inp(I_CRE)[(size_t)(g * 16 + c2) * 64 + p2], F.inp(I_CIM)[(size_t)(g * 16 + c2) * 64 + p2]};
    }
    __syncthreads();
    for (int e = tid; e < 4096; e += NTHR) {
        const int dl = e >> 8, c = (e >> 4) & 15, c2 = e & 15; float s = 0.f;
        for (int p = 0; p < 64; ++p) { const f32x2 cc = CC[c * 64 + p], pw = POW[dl * 64 + p], bb = BB[p * 16 + c2];
            const float wr_ = cc.x * pw.x - cc.y * pw.y, wi_ = cc.x * pw.y + cc.y * pw.x; s += wr_ * bb.x - wi_ * bb.y; }
        KD[e] = s;
    }
    __syncthreads();
    unsigned* TMo = WSP(unsigned, WS_TM) + (size_t)g * 256 * 192;
    for (int e = tid; e < 256 * 192; e += NTHR) {
        const int row = e / 192, kp = (e % 192) * 2, tau = row >> 4, c = row & 15; float v[2];
#pragma unroll
        for (int q = 0; q < 2; ++q) { const int k = kp + q;
            if (k < 256) { const int s = k >> 4, c2 = k & 15; v[q] = (s <= tau) ? KD[((tau - s) << 8) + (c << 4) + c2] + ((s == tau && c == c2) ? F.inp(I_S5D)[g * 16 + c] : 0.f) : 0.f; }
            else { const int j = k - 256, p = j & 63; const f32x2 cc = CC[c * 64 + p], pw = POW[(tau + 1) * 64 + p];
                v[q] = (j < 64) ? (cc.x * pw.x - cc.y * pw.y) : -(cc.x * pw.y + cc.y * pw.x); } }
        TMo[e] = pk2(v[0], v[1]);
    }
    unsigned* BKo = WSP(unsigned, WS_BKT) + (size_t)g * 128 * 128;
    for (int e = tid; e < 128 * 128; e += NTHR) {
        const int j = e >> 7, kp = (e & 127) * 2, p = j & 63; float v[2];
#pragma unroll
        for (int q = 0; q < 2; ++q) { const int k = kp + q, s = k >> 4, c = k & 15; const f32x2 pw = POW[(15 - s) * 64 + p], bb = BB[p * 16 + c];
            v[q] = (j < 64) ? (pw.x * bb.x - pw.y * bb.y) : (pw.x * bb.y + pw.y * bb.x); }
        BKo[e] = pk2(v[0], v[1]);
    }
    __syncthreads();
}
DI void p0_prologue(Frame& F) {
    if (F.bid < 64) p0_s5_group(F, F.bid);
    LAS unsigned* scr = (LAS unsigned*)(F.lds + F.wave * 16384);
    const int gw = F.bid * NWAVES + F.wave, NGW = F.G * NWAVES;
    for (int it = gw; it < P0_DENSE_ITEMS; it += NGW) p0_dense_item(F, it, scr);
    for (int it = gw; it < P0_MOE_ITEMS; it += NGW) p0_moe_item(F, it, scr);
    const size_t gt = (size_t)F.bid * NTHR + F.tid, NGT = (size_t)F.G * NTHR;
    for (size_t e = gt; e < 16 * 2048; e += NGT) { const int n = (int)(e >> 11), k = (int)(e & 2047); WSP(bf16, WS_WIN0T)[(size_t)(4096 + n) * 2048 + k] = f2bf(F.inp(I_ABWIN)[(size_t)k * ABC + 4096 + n]); }
    for (size_t e = gt; e < 2 * 64 * 2048; e += NGT) { const int l = (int)(e >> 17), n = (int)((e >> 11) & 63), k = (int)(e & 2047);
        const float w = F.inp(I_ROUTER)[((size_t)l * 2048 + k) * 64 + n]; const bf16 hi = f2bf(w); const bf16 lo = f2bf(w - bf2f(hi));
        WSP(bf16, WS_RT)[((size_t)(l * 2 + 0) * 64 + n) * 2048 + k] = hi; WSP(bf16, WS_RT)[((size_t)(l * 2 + 1) * 64 + n) * 2048 + k] = lo; }
    for (size_t e = gt; e < (size_t)TR * 512; e += NGT) { const size_t r = e >> 9, c4 = (e & 511) * 4;
        const f32x4 v = (r < TM) ? *(const f32x4*)(F.inp(I_X) + r * 2048 + c4) : *(const f32x4*)(F.inp(I_META) + (r - TM) * 2048 + c4);
        u32x2 o; o.x = pk2(v[0], v[1]); o.y = pk2(v[2], v[3]); *(u32x2*)(WSP(bf16, WS_XB) + r * 2048 + c4) = o; }
    for (size_t e = gt; e < (size_t)2064 * 128; e += NGT) { const int pos = (int)(e >> 7), j = (int)(e & 127);
        const float inv = exp2f(-(float)j * (13.287712379549449f / 128.0f)); float sn, cs; sincosf((float)pos * inv, &sn, &cs); WSP(f32x2, WS_ROPE)[e] = (f32x2){cs, sn}; }
}

DI f32x4 skinny_tile(const bf16* A0, size_t lda, const bf16* Bt, size_t ldb, int K, int lane) {
    const int r = lane & 15, q = lane >> 4;
    const bf16* ap = A0 + (size_t)r * lda + 8 * q; const bf16* bp = Bt + (size_t)r * ldb + 8 * q;
    f32x4 acc0 = {0.f, 0.f, 0.f, 0.f}, acc1 = {0.f, 0.f, 0.f, 0.f};
    for (int k = 0; k < K; k += 128) {
        const bf16x8 a0 = *(const bf16x8*)(ap + k), a1 = *(const bf16x8*)(ap + k + 32), a2 = *(const bf16x8*)(ap + k + 64), a3 = *(const bf16x8*)(ap + k + 96);
        const bf16x8 b0 = *(const bf16x8*)(bp + k), b1 = *(const bf16x8*)(bp + k + 32), b2 = *(const bf16x8*)(bp + k + 64), b3 = *(const bf16x8*)(bp + k + 96);
        acc0 = MFMA16(a0, b0, acc0); acc1 = MFMA16(a1, b1, acc1); acc0 = MFMA16(a2, b2, acc0); acc1 = MFMA16(a3, b3, acc1);
    }
    return acc0 + acc1;
}

DI void s5_unit(Frame& F, int b, int g) {
    LAS float* Gs = (LAS float*)(F.lds);
    LAS bf16* Hb = (LAS bf16*)(F.lds + 66048);
    const int w = F.wave, lane = F.lane, r = lane & 15, q = lane >> 4;
    const bf16* Ub = WSP(bf16, WS_U) + (size_t)(b * 64 + g) * 2048 * 16;
    const bf16* Um = WSP(bf16, WS_UMETA) + (size_t)g * 256;
    const bf16* BK = WSP(bf16, WS_BKT) + (size_t)g * 128 * 256;
    const bf16* TMg = WSP(bf16, WS_TM) + (size_t)g * 256 * 384;
    {
        f32x4 acc[8], accm[8];
#pragma unroll
        for (int n = 0; n < 8; ++n) { acc[n] = (f32x4){0.f, 0.f, 0.f, 0.f}; accm[n] = (f32x4){0.f, 0.f, 0.f, 0.f}; }
#pragma unroll 2
        for (int ks = 0; ks < 8; ++ks) {
            const bf16x8 a = *(const bf16x8*)(Ub + (size_t)(16 * w + r) * 256 + 32 * ks + 8 * q);
            const bf16x8 am = *(const bf16x8*)(Um + 32 * ks + 8 * q);
#pragma unroll
            for (int n = 0; n < 8; ++n) { const bf16x8 bb = *(const bf16x8*)(BK + (size_t)(16 * n + r) * 256 + 32 * ks + 8 * q);
                acc[n] = MFMA16(a, bb, acc[n]); if (w == 0) accm[n] = MFMA16(am, bb, accm[n]); }
        }
#pragma unroll
        for (int n = 0; n < 8; ++n) {
#pragma unroll
            for (int i = 0; i < 4; ++i) Gs[(16 * w + 4 * q + i) * 128 + 16 * n + r] = acc[n][i];
            if (w == 0 && q == 0) Gs[128 * 128 + 16 * n + r] = accm[n][0];
        }
    }
    __syncthreads();
    if (w == 0) {
        const int p = lane; const float ar = WSP(float, WS_A16)[(size_t)(g * 64 + p) * 2], ai = WSP(float, WS_A16)[(size_t)(g * 64 + p) * 2 + 1];
        float hr = Gs[128 * 128 + p], hi = Gs[128 * 128 + 64 + p];
        for (int n = 0; n < 128; ++n) {
            Hb[n * 128 + p] = f2bf(hr); Hb[n * 128 + 64 + p] = f2bf(hi);
            const float gr = Gs[n * 128 + p], gi = Gs[n * 128 + 64 + p];
            const float nr = ar * hr - ai * hi + gr, ni = ar * hi + ai * hr + gi; hr = nr; hi = ni;
        }
    } else {
        for (int e = (w - 1) * 64 + lane; e < 16 * 128; e += 7 * 64) Hb[128 * 128 + e] = 0;
    }
    __syncthreads();
    bf16* Zo = WSP(bf16, WS_Z);
#pragma unroll 1
    for (int pass = 0; pass < (b == 0 ? 3 : 2); ++pass) {
        const bool meta = pass == 2; const int nbase = meta ? 2 * w : 8 * pass, ncnt = meta ? 2 : 8;
        f32x4 acc[8];
#pragma unroll
        for (int n = 0; n < 8; ++n) acc[n] = (f32x4){0.f, 0.f, 0.f, 0.f};
        const int arow = meta ? 128 + r : 16 * w + r;
#pragma unroll 2
        for (int ks = 0; ks < 12; ++ks) {
            bf16x8 a;
            if (ks < 8) a = meta ? *(const bf16x8*)(Um + 32 * ks + 8 * q) : *(const bf16x8*)(Ub + (size_t)arow * 256 + 32 * ks + 8 * q);
            else a = *(const LAS bf16x8*)(Hb + arow * 128 + 32 * (ks - 8) + 8 * q);
#pragma unroll
            for (int n = 0; n < 8; ++n) if (n < ncnt) { const bf16x8 bb = *(const bf16x8*)(TMg + (size_t)(16 * (nbase + n) + r) * 384 + 32 * ks + 8 * q); acc[n] = MFMA16(a, bb, acc[n]); }
        }
#pragma unroll
        for (int n = 0; n < 8; ++n) if (n < ncnt) {
            const int tau = nbase + n;
            if (!meta) {
#pragma unroll
                for (int i = 0; i < 4; ++i) Zo[((size_t)b * 2048 + 16 * (16 * w + 4 * q + i) + tau) * 1024 + g * 16 + r] = f2bf(gelu_tanh(acc[n][i]));
            } else if (q == 0) Zo[((size_t)TM + tau) * 1024 + g * 16 + r] = f2bf(gelu_tanh(acc[n][0]));
        }
    }
    __syncthreads();
}

DI float logsig16(float x) { return (fminf(x, 0.f) - log1pf(__expf(-fabsf(x)))) * 0.0625f; }
DI void gla_pre_unit(Frame& F, int b, int n, int h) {
    LAS float* GLs = (LAS float*)(F.lds);
    LAS float* W2s = (LAS float*)(F.lds + 4096);
    LAS float* CAR = (LAS float*)(F.lds + 12288);
    LAS bf16* KnT = (LAS bf16*)(F.lds + 16384);
    const int tid = F.tid, j = tid & 127, tq = tid >> 7;
    const size_t row0 = (size_t)b * 2048 + 64 * n;
    for (int e = tid; e < 1024; e += NTHR) GLs[e] = WSP(float, WS_GL)[row0 * 16 + e];
    for (int e = tid; e < 2048; e += NTHR) W2s[e] = F.inp(I_GW2)[(size_t)(e >> 7) * 512 + h * 128 + (e & 127)];
    const float bias = F.inp(I_GBG)[h * 128 + j];
    __syncthreads();
    float bl[16]; float run = 0.f;
#pragma unroll
    for (int i = 0; i < 16; ++i) { const int t = tq * 16 + i; float x = bias;
#pragma unroll
        for (int rr = 0; rr < 16; ++rr) x += GLs[t * 16 + rr] * W2s[rr * 128 + j];
        run += logsig16(x); bl[i] = run; }
    CAR[tq * 128 + j] = run;
    __syncthreads();
    float off = 0.f, tot = 0.f;
#pragma unroll
    for (int t2 = 0; t2 < 4; ++t2) { const float c = CAR[t2 * 128 + j]; tot += c; off += (t2 < tq) ? c : 0.f; }
    const bf16* Qr = WSP(bf16, WS_QRAW); const bf16* Kr = WSP(bf16, WS_KRAW); bf16* QSo = WSP(bf16, WS_QS); bf16* KNo = WSP(bf16, WS_KN);
    float kn[16];
#pragma unroll
    for (int i = 0; i < 16; ++i) { const size_t row = row0 + tq * 16 + i; const float bb = bl[i] + off, e = __expf(bb), ei = __expf(-bb);
        const float qv = bf2f(Qr[row * 512 + h * 128 + j]), kv = bf2f(Kr[row * 512 + h * 128 + j]);
        QSo[row * 512 + h * 128 + j] = f2bf(qv * e); kn[i] = kv * ei; KNo[row * 512 + h * 128 + j] = f2bf(kn[i]); }
    { u32x4 o0, o1; o0.x = pk2(kn[0], kn[1]); o0.y = pk2(kn[2], kn[3]); o0.z = pk2(kn[4], kn[5]); o0.w = pk2(kn[6], kn[7]);
      o1.x = pk2(kn[8], kn[9]); o1.y = pk2(kn[10], kn[11]); o1.z = pk2(kn[12], kn[13]); o1.w = pk2(kn[14], kn[15]);
      *(LAS u32x4*)(KnT + j * 64 + tq * 16) = o0; *(LAS u32x4*)(KnT + j * 64 + tq * 16 + 8) = o1; }
    if (tq == 0) WSP(float, WS_DC0)[(size_t)(b * 32 + n) * 512 + h * 128 + j] = __expf(tot);
    __syncthreads();
    {
        const int w = F.wave, lane = F.lane, r = lane & 15, q = lane >> 4;
        const bf16* VT = WSP(bf16, WS_VT0) + ((size_t)(b * 1024 + h * 256) * 2048 + 64 * n);
        bf16* STo = WSP(bf16, WS_ST0) + (size_t)((b * 4 + h) * 32 + n) * 256 * 128;
#pragma unroll
        for (int mi = 0; mi < 2; ++mi) {
            const int mt = 2 * w + mi;
            f32x4 acc[8];
#pragma unroll
            for (int nn = 0; nn < 8; ++nn) acc[nn] = (f32x4){0.f, 0.f, 0.f, 0.f};
#pragma unroll
            for (int ks = 0; ks < 2; ++ks) {
                const bf16x8 a = *(const bf16x8*)(VT + (size_t)(16 * mt + r) * 2048 + 32 * ks + 8 * q);
#pragma unroll
                for (int nn = 0; nn < 8; ++nn) { const bf16x8 bb = *(const LAS bf16x8*)(KnT + (16 * nn + r) * 64 + 32 * ks + 8 * q); acc[nn] = MFMA16(a, bb, acc[nn]); }
            }
#pragma unroll
            for (int nn = 0; nn < 8; ++nn)
#pragma unroll
                for (int i = 0; i < 4; ++i) STo[(size_t)(16 * mt + 4 * q + i) * 128 + 16 * nn + r] = f2bf(acc[nn][i]);
        }
    }
    __syncthreads();
}
DI void gla_meta_unit(Frame& F, int h) {
    LAS float* GLs = (LAS float*)(F.lds);
    LAS float* W2s = (LAS float*)(F.lds + 4096);
    LAS float* QSm = (LAS float*)(F.lds + 16384);
    LAS float* KNm = (LAS float*)(F.lds + 24576);
    LAS float* Vm = (LAS float*)(F.lds + 32768);
    LAS float* SC = (LAS float*)(F.lds + 49152);
    LAS float* Om = (LAS float*)(F.lds + 53248);
    LAS float* DCm = (LAS float*)(F.lds + 69632);
    const int tid = F.tid, j = tid & 127, tq = tid >> 7;
    const float* PM = WSP(float, WS_PMETA);
    for (int e = tid; e < 256; e += NTHR) GLs[e] = WSP(float, WS_GL)[(size_t)TM * 16 + e];
    for (int e = tid; e < 2048; e += NTHR) W2s[e] = F.inp(I_GW2)[(size_t)(e >> 7) * 512 + h * 128 + (e & 127)];
    for (int e = tid; e < 4096; e += NTHR) Vm[e] = PM[(size_t)(e >> 8) * ABC + 2048 + h * 256 + (e & 255)];
    __syncthreads();
    if (tq == 0) {
        const float bias = F.inp(I_GBG)[h * 128 + j]; float run = 0.f;
        for (int i = 0; i < 16; ++i) { float x = bias;
#pragma unroll
            for (int rr = 0; rr < 16; ++rr) x += GLs[i * 16 + rr] * W2s[rr * 128 + j];
            run += logsig16(x);
            QSm[i * 128 + j] = PM[(size_t)i * ABC + 1024 + h * 128 + j] * 0.08838834764831845f * __expf(run);
            KNm[i * 128 + j] = PM[(size_t)i * ABC + 1536 + h * 128 + j] * __expf(-run); }
        DCm[j] = __expf(run);
    }
    __syncthreads();
    {
        const float dc = DCm[j]; float* So = WSP(float, WS_SMETA0) + (size_t)h * 256 * 128;
        for (int d = 0; d < 64; ++d) { const int dv = tq * 64 + d; float s = 0.f;
#pragma unroll
            for (int i = 0; i < 16; ++i) s += KNm[i * 128 + j] * Vm[i * 256 + dv];
            So[(size_t)dv * 128 + j] = dc * s; }
    }
    if (tid < 256) { const int i = tid >> 4, s = tid & 15; float a = 0.f; for (int jj = 0; jj < 128; ++jj) a += QSm[i * 128 + jj] * KNm[s * 128 + jj]; SC[tid] = (s <= i) ? a : 0.f; }
    __syncthreads();
    { const int dv = tid & 255, ih = tid >> 8;
        for (int i2 = 0; i2 < 8; ++i2) { const int i = ih * 8 + i2; float o = 0.f;
#pragma unroll
            for (int s = 0; s < 16; ++s) o += SC[i * 16 + s] * Vm[s * 256 + dv];
            Om[i * 256 + dv] = o; } }
    __syncthreads();
    for (int rr = 0; rr < 2; ++rr) {
        const int i = F.wave * 2 + rr; float v[4], s = 0.f;
#pragma unroll
        for (int k = 0; k < 4; ++k) { v[k] = Om[i * 256 + F.lane + 64 * k]; s += v[k]; }
        const float mean = wave_sum(s) * (1.f / 256.f); float s2 = 0.f;
#pragma unroll
        for (int k = 0; k < 4; ++k) { v[k] -= mean; s2 += v[k] * v[k]; }
        const float rstd = 1.f / sqrtf(wave_sum(s2) * (1.f / 256.f) + LN_EPS);
#pragma unroll
        for (int k = 0; k < 4; ++k) { const int dv = F.lane + 64 * k;
            const float gate = siluf_(PM[(size_t)i * ABC + 3072 + h * 256 + dv]);
            WSP(bf16, WS_MIXED0)[(size_t)(TM + i) * 2048 + 1024 + h * 256 + dv] = f2bf(v[k] * rstd * F.inp(I_GNG)[h * 256 + dv] * gate); }
    }
    __syncthreads();
}
DI void gla_scan(Frame& F) {
    const size_t gt = (size_t)F.bid * NTHR + F.tid, NGT = (size_t)F.G * NTHR;
    for (size_t e = gt; e < (size_t)16 * 256 * 32; e += NGT) {
        const int bh = (int)(e >> 13), dv = (int)((e >> 5) & 255), dk = (int)(e & 31) * 4, b = bh >> 2, h = bh & 3;
        f32x4 s = *(const f32x4*)(WSP(float, WS_SMETA0) + ((size_t)h * 256 + dv) * 128 + dk);
        bf16* st = WSP(bf16, WS_ST0) + ((size_t)bh * 32 * 256 + dv) * 128 + dk;
        const float* dcp = WSP(float, WS_DC0) + (size_t)b * 32 * 512 + h * 128 + dk;
        for (int n = 0; n < 32; ++n) {
            u32x2* p = (u32x2*)(st + (size_t)n * 256 * 128); const u32x2 c = *p; const f32x4 dc = *(const f32x4*)(dcp + (size_t)n * 512);
            u32x2 o; o.x = pk2(s[0], s[1]); o.y = pk2(s[2], s[3]); *p = o;
            s[0] = dc[0] * (s[0] + bflo(c.x)); s[1] = dc[1] * (s[1] + bfhi(c.x)); s[2] = dc[2] * (s[2] + bflo(c.y)); s[3] = dc[3] * (s[3] + bfhi(c.y));
        }
    }
}
DI void gla_out_unit(Frame& F, int b, int n, int h) {
    LAS float* STA = (LAS float*)(F.lds);
    const int w = F.wave, lane = F.lane, r = lane & 15, q = lane >> 4, rb = w & 3, dh = w >> 2;
    const size_t row0 = (size_t)b * 2048 + 64 * n;
    const bf16* QSp = WSP(bf16, WS_QS) + row0 * 512 + h * 128; const bf16* KNp = WSP(bf16, WS_KN) + row0 * 512 + h * 128;
    const bf16* VT = WSP(bf16, WS_VT0) + ((size_t)(b * 1024 + h * 256 + dh * 128) * 2048 + 64 * n);
    const bf16* STp = WSP(bf16, WS_ST0) + ((size_t)((b * 4 + h) * 32 + n) * 256 + dh * 128) * 128;
    bf16x8 qf[4];
#pragma unroll
    for (int ks = 0; ks < 4; ++ks) qf[ks] = *(const bf16x8*)(QSp + (size_t)(16 * rb + r) * 512 + 32 * ks + 8 * q);
    f32x4 PT[4];
#pragma unroll
    for (int kb = 0; kb < 4; ++kb) { PT[kb] = (f32x4){0.f, 0.f, 0.f, 0.f};
        if (kb <= rb) {
#pragma unroll
            for (int ks = 0; ks < 4; ++ks) { const bf16x8 kf = *(const bf16x8*)(KNp + (size_t)(16 * kb + r) * 512 + 32 * ks + 8 * q); PT[kb] = MFMA16(kf, qf[ks], PT[kb]); }
            if (kb == rb) {
#pragma unroll
                for (int i = 0; i < 4; ++i) PT[kb][i] = (4 * q + i <= r) ? PT[kb][i] : 0.f; }
        } }
    f32x4 acc[8];
#pragma unroll
    for (int nn = 0; nn < 8; ++nn) acc[nn] = (f32x4){0.f, 0.f, 0.f, 0.f};
#pragma unroll
    for (int ks = 0; ks < 4; ++ks)
#pragma unroll
        for (int nn = 0; nn < 8; ++nn) { const bf16x8 sf = *(const bf16x8*)(STp + (size_t)(16 * nn + r) * 128 + 32 * ks + 8 * q); acc[nn] = MFMA16(qf[ks], sf, acc[nn]); }
#pragma unroll
    for (int s2 = 0; s2 < 2; ++s2) if (2 * s2 <= rb) {
        u32x4 pa; pa.x = pk2(PT[2 * s2][0], PT[2 * s2][1]); pa.y = pk2(PT[2 * s2][2], PT[2 * s2][3]); pa.z = pk2(PT[2 * s2 + 1][0], PT[2 * s2 + 1][1]); pa.w = pk2(PT[2 * s2 + 1][2], PT[2 * s2 + 1][3]);
        const bf16x8 af = __builtin_bit_cast(bf16x8, pa);
#pragma unroll
        for (int nn = 0; nn < 8; ++nn) { const bf16* vp = VT + (size_t)(16 * nn + r) * 2048 + 32 * s2 + 4 * q;
            const u32x2 v0 = *(const u32x2*)vp, v1 = *(const u32x2*)(vp + 16); u32x4 vb; vb.x = v0.x; vb.y = v0.y; vb.z = v1.x; vb.w = v1.y;
            acc[nn] = MFMA16(af, __builtin_bit_cast(bf16x8, vb), acc[nn]); }
    }
    float sm[4], sq[4];
#pragma unroll
    for (int i = 0; i < 4; ++i) { float a = 0.f, c = 0.f;
#pragma unroll
        for (int nn = 0; nn < 8; ++nn) { a += acc[nn][i]; c += acc[nn][i] * acc[nn][i]; }
#pragma unroll
        for (int o = 1; o < 16; o <<= 1) { a += __shfl_xor(a, o); c += __shfl_xor(c, o); }
        sm[i] = a; sq[i] = c; }
    if (r == 0) {
#pragma unroll
        for (int i = 0; i < 4; ++i) { STA[(dh * 64 + 16 * rb + 4 * q + i) * 2] = sm[i]; STA[(dh * 64 + 16 * rb + 4 * q + i) * 2 + 1] = sq[i]; } }
    __syncthreads();
    const bf16* Rp = WSP(bf16, WS_R); bf16* MX = WSP(bf16, WS_MIXED0);
#pragma unroll
    for (int i = 0; i < 4; ++i) {
        const int rl = 16 * rb + 4 * q + i; const float s = STA[rl * 2] + STA[(64 + rl) * 2], s2 = STA[rl * 2 + 1] + STA[(64 + rl) * 2 + 1];
        const float mean = s * (1.f / 256.f), var = fmaxf(s2 * (1.f / 256.f) - mean * mean, 0.f), rstd = 1.f / sqrtf(var + LN_EPS);
        const size_t row = row0 + rl;
#pragma unroll
        for (int nn = 0; nn < 8; ++nn) { const int dv = h * 256 + dh * 128 + 16 * nn + r;
            MX[row * 2048 + 1024 + dv] = f2bf((acc[nn][i] - mean) * rstd * F.inp(I_GNG)[dv] * bf2f(Rp[row * 1024 + dv])); }
    }
    __syncthreads();
}
DI float skinny_block(Frame& F, const bf16* A0, size_t lda, const bf16* Bt, size_t ldb, int K) {
    LAS float* PART = (LAS float*)(F.lds);
    const int ksl = K >> 3, lane = F.lane, c = lane & 15, q = lane >> 4;
    const f32x4 a = skinny_tile(A0 + F.wave * ksl, lda, Bt + F.wave * ksl, ldb, ksl, lane);
    __syncthreads();
#pragma unroll
    for (int i = 0; i < 4; ++i) PART[F.wave * 256 + (4 * q + i) * 16 + c] = a[i];
    __syncthreads();
    float v = 0.f;
    if (F.tid < 256) {
#pragma unroll
        for (int w = 0; w < 8; ++w) v += PART[w * 256 + F.tid]; }
    return v;
}
DI void p1_skinny(Frame& F) {
    const bf16* XB = WSP(bf16, WS_XB); const bf16* WT = WSP(bf16, WS_WIN0T);
    const int tok = F.tid >> 4, c = F.tid & 15;
    for (int t = F.bid; t < 257 + 512; t += F.G) {
        if (t < 257) {
            const float a = skinny_block(F, XB + (size_t)TM * 2048, 2048, WT + (size_t)t * 16 * 2048, 2048, 2048);
            if (F.tid < 256) { WSP(float, WS_PMETA)[(size_t)tok * ABC + t * 16 + c] = a;
                if (t < 64) WSP(bf16, WS_UMETA)[(size_t)(t * 16 + tok) * 16 + c] = f2bf(a);
                if (t == 256) WSP(float, WS_GL)[(size_t)(TM + tok) * 16 + c] = a; }
        } else {
            const int rbk = t - 257;
            const float a = skinny_block(F, XB + (size_t)rbk * 16 * 2048, 2048, WT + (size_t)4096 * 2048, 2048, 2048);
            if (F.tid < 256) WSP(float, WS_GL)[(size_t)(rbk * 16 + tok) * 16 + c] = a;
        }
    }
}
DI void glu_meta_skinny(Frame& F) {
    const bf16* Z = WSP(bf16, WS_Z); const int tok = F.tid >> 4, c = F.tid & 15;
    for (int t = F.bid; t < 64; t += F.G) {
        const float a = skinny_block(F, Z + (size_t)TM * 1024, 1024, WSP(bf16, WS_WGLUT) + (size_t)t * 16 * 1024, 1024, 1024);
        if (F.tid < 256) { const size_t row = TM + tok; const int col = t * 16 + c; WSP(bf16, WS_MIXED0)[row * 2048 + col] = f2bf(bf2f(Z[row * 1024 + col]) * sigmoidf_(a)); }
    }
}
DI void out0_meta_skinny(Frame& F) {
    const int tok = F.tid >> 4, c = F.tid & 15;
    for (int t = F.bid; t < 128; t += F.G) {
        const float a = skinny_block(F, WSP(bf16, WS_MIXED0) + (size_t)TM * 2048, 2048, WSP(bf16, WS_WOUT0T) + (size_t)t * 16 * 2048, 2048, 2048);
        if (F.tid < 256) { const int col = t * 16 + c; WSP(float, WS_Y0)[(size_t)(TM + tok) * 2048 + col] = a + ALPHA * F.inp(I_META)[(size_t)tok * 2048 + col]; }
    }
}
DI void kv1_meta_skinny(Frame& F) {
    const int tok = F.tid >> 4, c = F.tid & 15;
    for (int t = F.bid; t < 384; t += F.G) {
        const float a = skinny_block(F, WSP(bf16, WS_H2B) + (size_t)TM * 2048, 2048, WSP(bf16, WS_WIN1T) + (size_t)(2048 + t * 16) * 2048, 2048, 2048);
        if (F.tid < 256) WSP(float, WS_KVMETA)[(size_t)tok * 6144 + t * 16 + c] = a;
    }
}

DI void ln_router_phase(Frame& F, int l, int ntok, int cbank) {
    const int lane = F.lane, r = lane & 15, q = lane >> 4, w = F.wave;
    LAS float* PART = (LAS float*)(F.lds);
    LAS float* Ss = (LAS float*)(F.lds + 32768);
    LAS float* SBs = (LAS float*)(F.lds + 36864);
    LAS int* LCNT = (LAS int*)(F.lds + 45056);
    LAS int* BASE = (LAS int*)(F.lds + 45312);
    LAS int* SELE = (LAS int*)(F.lds + 45568);
    if (F.tid < 64) LCNT[F.tid] = 0;
    __syncthreads();
    const float* Y0 = WSP(float, WS_Y0); float* H1F = WSP(float, WS_H1F); bf16* H1B = WSP(bf16, WS_H1B);
    const float* gam = F.inp(I_LN1G) + (size_t)l * 2048; const float* bet = F.inp(I_LN1B) + (size_t)l * 2048;
    const bf16* RH = WSP(bf16, WS_RT) + (size_t)(l * 2 + 0) * 64 * 2048; const bf16* RL = WSP(bf16, WS_RT) + (size_t)(l * 2 + 1) * 64 * 2048;
    const float* mbias = F.inp(I_MBIAS) + l * 64;
    unsigned* cnt = WSP(unsigned, WS_CTL) + CW_CNT + 4096 * cbank;
    int* ROWIDX = WSP(int, WS_ROWIDX); int* EIDX = WSP(int, WS_ROUTE); int* EPOS = EIDX + TR * 8; float* EW = (float*)(EPOS + TR * 8);
    int ti = 0;
    for (int t = F.bid; t * 16 < ntok; t += F.G, ++ti) {
        {
            const size_t row = (size_t)t * 16 + 2 * w;
            const f32x4* xr = (const f32x4*)(Y0 + row * 2048) + lane; f32x4 v0[8], v1[8]; float s0 = 0.f, s1 = 0.f;
#pragma unroll
            for (int k = 0; k < 8; ++k) { v0[k] = xr[64 * k]; v1[k] = xr[512 + 64 * k]; }
#pragma unroll
            for (int k = 0; k < 8; ++k) { s0 += (v0[k][0] + v0[k][1]) + (v0[k][2] + v0[k][3]); s1 += (v1[k][0] + v1[k][1]) + (v1[k][2] + v1[k][3]); }
#pragma unroll
            for (int o = 1; o < 64; o <<= 1) { s0 += __shfl_xor(s0, o); s1 += __shfl_xor(s1, o); }
            const float m0 = s0 * (1.f / 2048.f), m1 = s1 * (1.f / 2048.f); float q0 = 0.f, q1 = 0.f;
#pragma unroll
            for (int k = 0; k < 8; ++k) { v0[k] = v0[k] - m0; v1[k] = v1[k] - m1;
                q0 += (v0[k][0] * v0[k][0] + v0[k][1] * v0[k][1]) + (v0[k][2] * v0[k][2] + v0[k][3] * v0[k][3]);
                q1 += (v1[k][0] * v1[k][0] + v1[k][1] * v1[k][1]) + (v1[k][2] * v1[k][2] + v1[k][3] * v1[k][3]); }
#pragma unroll
            for (int o = 1; o < 64; o <<= 1) { q0 += __shfl_xor(q0, o); q1 += __shfl_xor(q1, o); }
            const float r0 = 1.f / sqrtf(q0 * (1.f / 2048.f) + LN_EPS), r1 = 1.f / sqrtf(q1 * (1.f / 2048.f) + LN_EPS);
#pragma unroll
            for (int k = 0; k < 8; ++k) { const f32x4 g4 = *((const f32x4*)gam + lane + 64 * k), b4 = *((const f32x4*)bet + lane + 64 * k);
                const f32x4 y0 = v0[k] * r0 * g4 + b4, y1 = v1[k] * r1 * g4 + b4;
                *((f32x4*)(H1F + row * 2048) + lane + 64 * k) = y0; *((f32x4*)(H1F + (row + 1) * 2048) + lane + 64 * k) = y1;
                u32x2 o; o.x = pk2(y0[0], y0[1]); o.y = pk2(y0[2], y0[3]); *((u32x2*)(H1B + row * 2048) + lane + 64 * k) = o;
                o.x = pk2(y1[0], y1[1]); o.y = pk2(y1[2], y1[3]); *((u32x2*)(H1B + (row + 1) * 2048) + lane + 64 * k) = o; }
        }
        VM_WAIT(); __syncthreads();
        f32x4 acc[4];
#pragma unroll
        for (int n = 0; n < 4; ++n) acc[n] = (f32x4){0.f, 0.f, 0.f, 0.f};
        const float* ap = H1F + ((size_t)t * 16 + r) * 2048 + 256 * w + 8 * q;
        const bf16* rh = RH + (size_t)r * 2048 + 256 * w + 8 * q; const bf16* rl = RL + (size_t)r * 2048 + 256 * w + 8 * q;
#pragma unroll 4
        for (int ks = 0; ks < 8; ++ks) {
            const f32x4 x0 = *(const f32x4*)(ap + 32 * ks), x1 = *(const f32x4*)(ap + 32 * ks + 4);
            u32x4 hi, lo;
            hi.x = pk2(x0[0], x0[1]); hi.y = pk2(x0[2], x0[3]); hi.z = pk2(x1[0], x1[1]); hi.w = pk2(x1[2], x1[3]);
            lo.x = pk2(x0[0] - bflo(hi.x), x0[1] - bfhi(hi.x)); lo.y = pk2(x0[2] - bflo(hi.y), x0[3] - bfhi(hi.y));
            lo.z = pk2(x1[0] - bflo(hi.z), x1[1] - bfhi(hi.z)); lo.w = pk2(x1[2] - bflo(hi.w), x1[3] - bfhi(hi.w));
            const bf16x8 ah = __builtin_bit_cast(bf16x8, hi), al = __builtin_bit_cast(bf16x8, lo);
#pragma unroll
            for (int n = 0; n < 4; ++n) { const bf16x8 bh = *(const bf16x8*)(rh + (size_t)(16 * n) * 2048 + 32 * ks), bl = *(const bf16x8*)(rl + (size_t)(16 * n) * 2048 + 32 * ks);
                acc[n] = MFMA16(ah, bh, acc[n]); acc[n] = MFMA16(al, bh, acc[n]); acc[n] = MFMA16(ah, bl, acc[n]); }
        }
#pragma unroll
        for (int n = 0; n < 4; ++n)
#pragma unroll
            for (int i = 0; i < 4; ++i) PART[(w * 16 + 4 * q + i) * 64 + 16 * n + r] = acc[n][i];
        __syncthreads();
#pragma unroll
        for (int oo = 0; oo < 2; ++oo) { const int o = F.tid * 2 + oo; float a = 0.f;
#pragma unroll
            for (int ww = 0; ww < 8; ++ww) a += PART[ww * 1024 + o];
            const float sg = sigmoidf_(a); Ss[o] = sg; SBs[o] = sg + mbias[o & 63]; }
        __syncthreads();
        if (w == 0) {
            const int row = t * 16 + r;
            float x[16];
#pragma unroll
            for (int k = 0; k < 16; ++k) x[k] = SBs[r * 64 + 16 * q + k];
            float gsum[2];
#pragma unroll
            for (int gg = 0; gg < 2; ++gg) { float m1 = -INFINITY, m2 = -INFINITY;
#pragma unroll
                for (int k = 0; k < 8; ++k) { const float xv = x[8 * gg + k]; const bool gt1 = xv > m1; m2 = gt1 ? m1 : fmaxf(m2, xv); m1 = gt1 ? xv : m1; }
                gsum[gg] = m1 + m2; }
            float gs[8];
#pragma unroll
            for (int qq = 0; qq < 4; ++qq) { gs[2 * qq] = __shfl(gsum[0], qq * 16 + r); gs[2 * qq + 1] = __shfl(gsum[1], qq * 16 + r); }
#pragma unroll
            for (int gg = 0; gg < 2; ++gg) { const int gi = 2 * q + gg; int rank = 0; const float mine = gsum[gg];
#pragma unroll
                for (int k = 0; k < 8; ++k) rank += (gs[k] > mine || (gs[k] == mine && k < gi)) ? 1 : 0;
                if (rank >= 4) {
#pragma unroll
                    for (int k = 0; k < 8; ++k) x[8 * gg + k] = -INFINITY; } }
            int me0 = 0, me1 = 0; float mw0 = 0.f, mw1 = 0.f, wsum = 0.f;
#pragma unroll 1
            for (int kk = 0; kk < 8; ++kk) {
                float bv = x[0]; int bk = 0;
#pragma unroll
                for (int k = 1; k < 16; ++k) { const bool g = x[k] > bv; bv = g ? x[k] : bv; bk = g ? k : bk; }
                int bi = 16 * q + bk;
#pragma unroll
                for (int o = 16; o < 64; o <<= 1) { const float ov = __shfl_xor(bv, o); const int oi = __shfl_xor(bi, o); if (ov > bv || (ov == bv && oi < bi)) { bv = ov; bi = oi; } }
                const float wv = Ss[r * 64 + bi]; wsum += wv;
#pragma unroll
                for (int k = 0; k < 16; ++k) x[k] = (16 * q + k == bi) ? -INFINITY : x[k];
                if ((kk >> 1) == q) { if (kk & 1) { me1 = bi; mw1 = wv; } else { me0 = bi; mw0 = wv; } }
            }
            if (row < ntok) {
                const float sc = 2.5f / wsum;
                const int l0 = __hip_atomic_fetch_add(LCNT + me0, 1, __ATOMIC_RELAXED, __HIP_MEMORY_SCOPE_WORKGROUP), l1 = __hip_atomic_fetch_add(LCNT + me1, 1, __ATOMIC_RELAXED, __HIP_MEMORY_SCOPE_WORKGROUP);
                SELE[ti * 128 + r * 8 + 2 * q] = me0 | (l0 << 8); SELE[ti * 128 + r * 8 + 2 * q + 1] = me1 | (l1 << 8);
                EIDX[row * 8 + 2 * q] = me0; EIDX[row * 8 + 2 * q + 1] = me1;
                EW[row * 8 + 2 * q] = mw0 * sc; EW[row * 8 + 2 * q + 1] = mw1 * sc;
                if (q == 0) ROWIDX[(size_t)NE * TRP + row] = row;
            }
        }
        __syncthreads();
    }
    if (F.tid < 64) { const int c = LCNT[F.tid]; BASE[F.tid] = c ? (int)atomicAdd(cnt + 32 * F.tid, (unsigned)c) : 0; }
    __syncthreads();
    for (int idx = F.tid; idx < ti * 128; idx += NTHR) {
        const int tt = idx >> 7, j = idx & 127, row = (F.bid + tt * F.G) * 16 + (j >> 3), v = SELE[idx], e = v & 255, pos = BASE[e] + (v >> 8);
        EPOS[row * 8 + (j & 7)] = pos; ROWIDX[(size_t)e * TRP + pos] = row;
    }
    __syncthreads();
}
DI int moe_tables(Frame& F, int l, int ntok, volatile LAS int* TP, volatile LAS int* CN, volatile LAS int* LST) {
    if (F.tid < NEX) CN[F.tid] = (F.tid < NE) ? (int)__hip_atomic_load(WSP(unsigned, WS_CTL) + CW_CNT + 4096 * l + 32 * F.tid, RLX_AGENT) : ntok;
    __syncthreads();
    if (F.tid == 0) {
        int a = 0; for (int e = 0; e < NEX; ++e) { TP[e] = a; a += (CN[e] + 255) >> 8; } TP[NEX] = a;
        const int v = F.bid & 7; int n = 0, load[8];
#pragma unroll
        for (int k = 0; k < 8; ++k) load[k] = 0;
        for (int e = 0; e < NE; ++e) { const int te = TP[e + 1] - TP[e];
#pragma unroll
            for (int k = 0; k < 8; ++k) load[k] += ((e & 7) == k) ? te : 0;
            if ((e & 7) == v) for (int j = 0; j < te; ++j) LST[n++] = (e << 16) | (TP[e] + j); }
        const int tsh = TP[NEX] - TP[NE];
        for (int sidx = 0; sidx < tsh; ++sidx) { int best = 0, bl = load[0];
#pragma unroll
            for (int k = 1; k < 8; ++k) if (load[k] < bl) { bl = load[k]; best = k; }
#pragma unroll
            for (int k = 0; k < 8; ++k) load[k] += (k == best) ? 1 : 0;
            if (best == v) LST[n++] = (NE << 16) | (TP[NE] + sidx); }
        LST[1023] = n;
    }
    __syncthreads();
    return __builtin_amdgcn_readfirstlane(LST[1023]);
}
DI void combine_ln_phase(Frame& F, int l, int ntok, volatile LAS int* TP) {
    const int gw = F.bid * NWAVES + F.wave, NGW = F.G * NWAVES, lane = F.lane;
    const float* H1F = WSP(float, WS_H1F); const bf16* YB = WSP(bf16, WS_YBUF);
    const int* EIDX = WSP(int, WS_ROUTE); const int* EPOS = EIDX + TR * 8; const float* EW = (const float*)(EPOS + TR * 8);
    const float* gam = F.inp(I_LN2G) + (size_t)l * 2048; const float* bet = F.inp(I_LN2B) + (size_t)l * 2048;
    for (int row = gw; row < ntok; row += NGW) {
        f32x4 v[8];
#pragma unroll
        for (int k = 0; k < 8; ++k) v[k] = ALPHA * *((const f32x4*)(H1F + (size_t)row * 2048) + lane + 64 * k);
        for (int kk = 0; kk < 9; ++kk) {
            int slot; float w;
            if (kk < 8) { const int e = EIDX[row * 8 + kk]; slot = TP[e] * 256 + EPOS[row * 8 + kk]; w = EW[row * 8 + kk]; } else { slot = TP[NE] * 256 + row; w = 1.f; }
            const u32x2* yp = (const u32x2*)(YB + (size_t)slot * 2048) + lane;
#pragma unroll
            for (int k = 0; k < 8; ++k) { const u32x2 y = yp[64 * k]; v[k][0] += w * bflo(y.x); v[k][1] += w * bfhi(y.x); v[k][2] += w * bflo(y.y); v[k][3] += w * bfhi(y.y); }
        }
        float s = 0.f;
#pragma unroll
        for (int k = 0; k < 8; ++k) s += (v[k][0] + v[k][1]) + (v[k][2] + v[k][3]);
        const float mean = wave_sum(s) * (1.f / 2048.f); float s2 = 0.f;
#pragma unroll
        for (int k = 0; k < 8; ++k) { v[k] = v[k] - mean; s2 += (v[k][0] * v[k][0] + v[k][1] * v[k][1]) + (v[k][2] * v[k][2] + v[k][3] * v[k][3]); }
        const float rstd = 1.f / sqrtf(wave_sum(s2) * (1.f / 2048.f) + LN_EPS);
#pragma unroll
        for (int k = 0; k < 8; ++k) { const f32x4 g4 = *((const f32x4*)gam + lane + 64 * k), b4 = *((const f32x4*)bet + lane + 64 * k);
            const f32x4 y = v[k] * rstd * g4 + b4;
            if (l == 0) { *((f32x4*)(WSP(float, WS_H2F) + (size_t)row * 2048) + lane + 64 * k) = y;
                u32x2 o; o.x = pk2(y[0], y[1]); o.y = pk2(y[2], y[3]); *((u32x2*)(WSP(bf16, WS_H2B) + (size_t)row * 2048) + lane + 64 * k) = o; }
            else *((f32x4*)(F.out + (size_t)row * 2048) + lane + 64 * k) = y; }
    }
}
DI void ret_scan(Frame& F) {
    const size_t gt = (size_t)F.bid * NTHR + F.tid, NGT = (size_t)F.G * NTHR;
    const float* KV = WSP(float, WS_KVMETA); const f32x2* rope = WSP(f32x2, WS_ROPE);
    for (size_t e = gt; e < (size_t)32 * 512 * 32; e += NGT) {
        const int bh = (int)(e >> 14), dv = (int)((e >> 5) & 511), dk0 = (int)(e & 31) * 8, h = bh & 7;
        const float l2g = lg2gamma(h), g256 = exp2f(256.f * l2g);
        float s[8];
#pragma unroll
        for (int i = 0; i < 8; ++i) s[i] = 0.f;
        for (int m = 0; m < 16; ++m) {
            const float vm = KV[(size_t)m * 6144 + 2048 + h * 512 + dv] * 0.0625f * exp2f((float)(15 - m) * l2g);
#pragma unroll
            for (int i = 0; i < 8; ++i) { const int dk = dk0 + i, j = dk & 127; const f32x2 cs = rope[(size_t)m * 128 + j];
                const float k1 = KV[(size_t)m * 6144 + h * 256 + j], k2 = KV[(size_t)m * 6144 + h * 256 + 128 + j];
                const float kr = (dk < 128) ? (k1 * cs.x - k2 * cs.y) : (k1 * cs.y + k2 * cs.x);
                s[i] += kr * vm; }
        }
        bf16* vs = WSP(bf16, WS_VS) + ((size_t)bh * 8 * 512 + dv) * 512 + 256 + dk0;
        for (int sc = 0; sc < 8; ++sc) {
            u32x4* p = (u32x4*)(vs + (size_t)sc * 512 * 512); const u32x4 c = *p;
            u32x4 o; o.x = pk2(s[0], s[1]); o.y = pk2(s[2], s[3]); o.z = pk2(s[4], s[5]); o.w = pk2(s[6], s[7]); *p = o;
            s[0] = g256 * (s[0] + bflo(c.x)); s[1] = g256 * (s[1] + bfhi(c.x)); s[2] = g256 * (s[2] + bflo(c.y)); s[3] = g256 * (s[3] + bfhi(c.y));
            s[4] = g256 * (s[4] + bflo(c.z)); s[5] = g256 * (s[5] + bfhi(c.z)); s[6] = g256 * (s[6] + bflo(c.w)); s[7] = g256 * (s[7] + bfhi(c.w));
        }
    }
}
DI void ret_norm_phase(Frame& F) {
    const int gw = F.bid * NWAVES + F.wave, NGW = F.G * NWAVES, lane = F.lane;
    const bf16* O = WSP(bf16, WS_O1); const bf16* GT = WSP(bf16, WS_GATE1); bf16* MX = WSP(bf16, WS_MIXED1);
    for (int row = gw; row < TM; row += NGW) {
#pragma unroll 2
        for (int h = 0; h < 8; ++h) {
            const size_t off = (size_t)row * 4096 + h * 512 + 8 * lane;
            const u32x4 o = *(const u32x4*)(O + off), g = *(const u32x4*)(GT + off);
            float v[8] = {bflo(o.x), bfhi(o.x), bflo(o.y), bfhi(o.y), bflo(o.z), bfhi(o.z), bflo(o.w), bfhi(o.w)};
            const float gv[8] = {bflo(g.x), bfhi(g.x), bflo(g.y), bfhi(g.y), bflo(g.z), bfhi(g.z), bflo(g.w), bfhi(g.w)};
            float s = 0.f;
#pragma unroll
            for (int i = 0; i < 8; ++i) s += v[i];
            const float mean = wave_sum(s) * (1.f / 512.f); float s2 = 0.f;
#pragma unroll
            for (int i = 0; i < 8; ++i) { v[i] -= mean; s2 += v[i] * v[i]; }
            const float rstd = 1.f / sqrtf(wave_sum(s2) * (1.f / 512.f) + LN_EPS);
            const f32x4 g0 = *(const f32x4*)(F.inp(I_RNG) + h * 512 + 8 * lane), g1 = *(const f32x4*)(F.inp(I_RNG) + h * 512 + 8 * lane + 4);
            u32x4 w; w.x = pk2(v[0] * rstd * g0[0] * gv[0], v[1] * rstd * g0[1] * gv[1]); w.y = pk2(v[2] * rstd * g0[2] * gv[2], v[3] * rstd * g0[3] * gv[3]);
            w.z = pk2(v[4] * rstd * g1[0] * gv[4], v[5] * rstd * g1[1] * gv[5]); w.w = pk2(v[6] * rstd * g1[2] * gv[6], v[7] * rstd * g1[3] * gv[7]);
            *(u32x4*)(MX + off) = w;
        }
    }
}

DI void kn_transpose_pass(Frame& F) {
    LAS unsigned* T = (LAS unsigned*)(F.lds + F.wave * 16384);
    const int gw = F.bid * NWAVES + F.wave, NGW = F.G * NWAVES, lane = F.lane;
    const bf16* KN = WSP(bf16, WS_KN1); bf16* KT = WSP(bf16, WS_KNT1);
    const int pr = lane >> 3, ch = lane & 7;
    for (int it = gw; it < 128 * 32; it += NGW) {
        const int tb = it >> 5, cb = it & 31, row0 = tb * 64, col0 = cb * 64, b = row0 >> 11, s0 = row0 & 2047;
        u32x4 va[4], vb[4];
#pragma unroll
        for (int j = 0; j < 4; ++j) { const bf16* p = KN + (size_t)(row0 + 16 * j + 2 * pr) * 2048 + col0 + 8 * ch; va[j] = *(const u32x4*)p; vb[j] = *(const u32x4*)(p + 2048); }
#pragma unroll
        for (int j = 0; j < 4; ++j) { const int tp = 8 * j + pr;
            const unsigned a[4] = {va[j].x, va[j].y, va[j].z, va[j].w}, c[4] = {vb[j].x, vb[j].y, vb[j].z, vb[j].w};
#pragma unroll
            for (int i = 0; i < 4; ++i) { T[(8 * ch + 2 * i) * 33 + tp] = (a[i] & 0xffffu) | (c[i] << 16); T[(8 * ch + 2 * i + 1) * 33 + tp] = (a[i] >> 16) | (c[i] & 0xffff0000u); } }
        LDS_WAIT(); asm volatile("" ::: "memory");
#pragma unroll
        for (int j = 0; j < 8; ++j) { const int n = 8 * j + pr; const LAS unsigned* t = T + n * 33 + 4 * ch;
            u32x4 o; o.x = t[0]; o.y = t[1]; o.z = t[2]; o.w = t[3];
            *(u32x4*)(KT + ((size_t)(b * 2048 + col0 + n) * 2048 + s0 + 8 * ch)) = o; }
        LDS_WAIT(); asm volatile("" ::: "memory");
    }
}
struct Args { const float* in[31]; float* out; unsigned char* ws; int ph_lo, ph_hi, li, pad; };
constexpr int NPHASE = 22;

__global__ void __launch_bounds__(NTHR, 2) mk_fwd(Args args) {
    extern __shared__ __attribute__((aligned(16))) unsigned char lds_raw[];
    Frame F;
    F.lds = (LAS unsigned char*)lds_raw;
    F.tid = threadIdx.x; F.lane = F.tid & 63; F.wave = __builtin_amdgcn_readfirstlane(F.tid >> 6);
    F.G = gridDim.x; F.bid = blockIdx.x; F.ws = args.ws; F.out = args.out;
    volatile LAS unsigned* MISC = (volatile LAS unsigned*)(F.lds + MISC_OFF);
    volatile LAS int* TP = (volatile LAS int*)(F.lds + MISC_OFF + 256);
    volatile LAS int* CN = (volatile LAS int*)(F.lds + MISC_OFF + 640);
    volatile LAS int* LST = (volatile LAS int*)(F.lds + MISC_OFF + 4096);
    for (int u = F.tid; u < (LDS_BYTES - MISC_OFF) / 4; u += NTHR) MISC[u] = 0u;
    __syncthreads();
    if (F.tid < 31) { const unsigned long long p = (unsigned long long)args.in[F.tid]; MISC[512 + 2 * F.tid] = (unsigned)p; MISC[512 + 2 * F.tid + 1] = (unsigned)(p >> 32); }
    __syncthreads();
    XcdBarrier bar = xcd_barrier_post(WSP(unsigned, WS_CTL) + CW_BAR + args.li * XCD_BAR_WORDS, MISC + 8);
    const int lo = args.ph_lo, hi = args.ph_hi;
#ifndef PHMASK
#define PHMASK 0x3fffff
#endif
#define IN(k) (((PHMASK >> (k)) & 1) && lo <= (k) && (k) < hi)
#ifndef PROBE_STAMP
#define PROBE_STAMP (-1)
#endif
    unsigned long long pst0 = 0ull, pst1 = 0ull;
    if (PROBE_STAMP == 0) pst0 = __builtin_amdgcn_s_memrealtime();
#define SEAM(k) do { if (IN(k) && IN((k) + 1)) xcd_barrier(bar); if (PROBE_STAMP == (k)) pst1 = __builtin_amdgcn_s_memrealtime(); if (PROBE_STAMP == (k) + 1) pst0 = __builtin_amdgcn_s_memrealtime(); } while (0)
    LAS unsigned char* ring = F.lds;
    const int G = F.G, bid = F.bid;

    if (IN(0)) { p0_prologue(F); }
    SEAM(0);
    if (IN(1)) {
        p1_skinny(F);
        __syncthreads();
        { DenseSched S; S.init(WSP(bf16, WS_XB), 4096, WSP(bf16, WS_WIN0T), 4096, 2048, 32, 8, 0, 4, 12, G, bid);
          EpiIn0 E{WSP(bf16, WS_U), WSP(bf16, WS_QRAW), WSP(bf16, WS_KRAW), WSP(bf16, WS_R)};
          pg8::gemm_phase<EpiIn0, DenseSched, false>(ring, S, E); }
        { DenseSched S; S.init(WSP(bf16, WS_XB), 4096, WSP(bf16, WS_WIN0T), 4096, 2048, 32, 4, 8, 0, 0, G, (bid + G / 2) % G);
          EpiVT0 E{WSP(bf16, WS_VT0)};
          pg8::gemm_phase<EpiVT0, DenseSched, true>(ring, S, E); }
    }
    SEAM(1);
    if (IN(2)) {
        for (int u = bid; u < 256; u += G) s5_unit(F, u >> 6, u & 63);
        for (int u = bid; u < 516; u += G) { if (u < 512) gla_pre_unit(F, u >> 7, (u >> 2) & 31, u & 3); else gla_meta_unit(F, u - 512); }
    }
    SEAM(2);
    if (IN(3)) { gla_scan(F); }
    SEAM(3);
    if (IN(4)) {
        glu_meta_skinny(F);
        if (G == 256) {
            if (bid >= 128) { for (int k = 0; k < 3; ++k) { const int u = (bid - 128) + 128 * k; gla_out_unit(F, u >> 7, (u >> 2) & 31, u & 3); } }
            else { const int u = 384 + bid; gla_out_unit(F, u >> 7, (u >> 2) & 31, u & 3); }
        } else { for (int u = bid; u < 512; u += G) gla_out_unit(F, u >> 7, (u >> 2) & 31, u & 3); }
        __syncthreads();
        { DenseSched S; S.init(WSP(bf16, WS_Z), 2048, WSP(bf16, WS_WGLUT), 2048, 1024, 32, 4, 0, 0, 0, G, bid);
          EpiGlu E{WSP(bf16, WS_Z), WSP(bf16, WS_MIXED0)};
          pg8::gemm_phase<EpiGlu, DenseSched, false>(ring, S, E); }
    }
    SEAM(4);
    if (IN(5)) {
        out0_meta_skinny(F);
        __syncthreads();
        DenseSched S; S.init(WSP(bf16, WS_MIXED0), 4096, WSP(bf16, WS_WOUT0T), 4096, 2048, 32, 8, 0, 0, 0, G, bid);
        EpiOut E{F.inp(I_X), WSP(float, WS_Y0)};
        pg8::gemm_phase<EpiOut, DenseSched, false>(ring, S, E);
    }
    SEAM(5);
    if (IN(6)) { ln_router_phase(F, 0, TR, 0); }
    SEAM(6);
    if (IN(7)) {
        const int nlist = moe_tables(F, 0, TR, TP, CN, LST);
        MoeSchedGU S; S.lda = 4096; S.ldb = 4096; S.K = 2048; S.TP = TP; S.CNT = CN; S.A = (const char*)WSP(bf16, WS_H1B); S.B = (const char*)WSP(bf16, WS_WGU);
        S.rowidx = WSP(int, WS_ROWIDX); S.LST = LST; S.nlist = nlist; S.nloc = (G - (bid & 7) + 7) >> 3; S.rank = bid >> 3; S.bstride = (size_t)1024 * 2048 * 2;
        EpiMoeGU E{WSP(bf16, WS_HBUF)};
        pg8::gemm_phase<EpiMoeGU, MoeSchedGU, false>(ring, S, E);
    }
    SEAM(7);
    if (IN(8)) {
        const int nlist = moe_tables(F, 0, TR, TP, CN, LST);
        MoeSchedDN S; S.lda = 1024; S.ldb = 1024; S.K = 512; S.TP = TP; S.CNT = CN; S.A = (const char*)WSP(bf16, WS_HBUF); S.B = (const char*)WSP(bf16, WS_WD);
        S.rowidx = nullptr; S.LST = LST; S.nlist = nlist; S.nloc = (G - (bid & 7) + 7) >> 3; S.rank = bid >> 3; S.bstride = (size_t)2048 * 512 * 2;
        EpiMoeDN E{WSP(bf16, WS_YBUF)};
        pg8::gemm_phase<EpiMoeDN, MoeSchedDN, false>(ring, S, E);
    }
    SEAM(8);
    if (IN(9)) { (void)moe_tables(F, 0, TR, TP, CN, LST); combine_ln_phase(F, 0, TR, TP); }
    SEAM(9);
    if (IN(10)) {
        kv1_meta_skinny(F);
        __syncthreads();
        { DenseSched S; S.init(WSP(bf16, WS_H2B), 4096, WSP(bf16, WS_WIN1T), 4096, 2048, 32, 16, 0, 16, 32, G, bid);
          EpiIn1 E{WSP(bf16, WS_PQ), WSP(bf16, WS_KN1), WSP(bf16, WS_GATE1), WSP(f32x2, WS_ROPE)};
          pg8::gemm_phase<EpiIn1, DenseSched, false>(ring, S, E); }
    }
    SEAM(10);
    if (IN(11)) {
        { DenseSched S; S.init(WSP(bf16, WS_H2B), 4096, WSP(bf16, WS_WIN1T), 4096, 2048, 32, 16, 16, 0, 0, G, bid);
          EpiIn1T E{WSP(bf16, WS_KNT1), WSP(bf16, WS_VS), WSP(f32x2, WS_ROPE)};
          pg8::gemm_phase<EpiIn1T, DenseSched, true>(ring, S, E); }
        kn_transpose_pass(F);
    }
    SEAM(11);
    if (IN(12)) {
        BatchSched S; S.lda = 1024; S.ldb = 4096; S.K = 256; S.A = (const char*)WSP(bf16, WS_VS); S.B = (const char*)WSP(bf16, WS_KNT1);
        S.sA_g = (size_t)512 * 512 * 2; S.sA_j = (size_t)256 * 512 * 2; S.sB_b = (size_t)2048 * 2048 * 2; S.sB_h = (size_t)256 * 2048 * 2; S.sB_sc = 512; S.sB_g = 0; S.sB_j = 0;
        S.per = 2; S.n = 512; S.G = G; S.c = bid;
        EpiRetA E{WSP(bf16, WS_VS)};
        pg8::gemm_phase<EpiRetA, BatchSched, false>(ring, S, E);
    }
    SEAM(12);
    if (IN(13)) { ret_scan(F); }
    SEAM(13);
    if (IN(14)) {
        BatchSched S; S.lda = 1024; S.ldb = 4096; S.K = 256; S.A = (const char*)(WSP(bf16, WS_PQ) + 256); S.B = (const char*)WSP(bf16, WS_KN1);
        S.sA_g = (size_t)256 * 512 * 2; S.sA_j = 0; S.sB_b = (size_t)2048 * 2048 * 2; S.sB_h = 512; S.sB_sc = (size_t)256 * 2048 * 2; S.sB_g = 0; S.sB_j = 0;
        S.per = 1; S.n = 256; S.G = G; S.c = bid;
        EpiRetP E{WSP(bf16, WS_PQ)};
        pg8::gemm_phase<EpiRetP, BatchSched, false>(ring, S, E);
    }
    SEAM(14);
    if (IN(15)) {
        BatchSched S; S.lda = 1024; S.ldb = 1024; S.K = 512; S.A = (const char*)WSP(bf16, WS_PQ); S.B = (const char*)WSP(bf16, WS_VS);
        S.sA_g = (size_t)256 * 512 * 2; S.sA_j = 0; S.sB_b = 0; S.sB_h = 0; S.sB_sc = 0; S.sB_g = (size_t)512 * 512 * 2; S.sB_j = (size_t)256 * 512 * 2;
        S.per = 2; S.n = 512; S.G = G; S.c = bid;
        EpiRetO E{WSP(bf16, WS_O1)};
        pg8::gemm_phase<EpiRetO, BatchSched, false>(ring, S, E);
    }
    SEAM(15);
    if (IN(16)) { ret_norm_phase(F); }
    SEAM(16);
    if (IN(17)) {
        DenseSched S; S.init(WSP(bf16, WS_MIXED1), 8192, WSP(bf16, WS_WOUT1T), 8192, 4096, 32, 8, 0, 0, 0, G, bid);
        EpiOut E{WSP(float, WS_H2F), WSP(float, WS_Y0)};
        pg8::gemm_phase<EpiOut, DenseSched, false>(ring, S, E);
    }
    SEAM(17);
    if (IN(18)) { ln_router_phase(F, 1, TM, 1); }
    SEAM(18);
    if (IN(19)) {
        const int nlist = moe_tables(F, 1, TM, TP, CN, LST);
        MoeSchedGU S; S.lda = 4096; S.ldb = 4096; S.K = 2048; S.TP = TP; S.CNT = CN; S.A = (const char*)WSP(bf16, WS_H1B); S.B = (const char*)(WSP(bf16, WS_WGU) + (size_t)NEX * 1024 * 2048);
        S.rowidx = WSP(int, WS_ROWIDX); S.LST = LST; S.nlist = nlist; S.nloc = (G - (bid & 7) + 7) >> 3; S.rank = bid >> 3; S.bstride = (size_t)1024 * 2048 * 2;
        EpiMoeGU E{WSP(bf16, WS_HBUF)};
        pg8::gemm_phase<EpiMoeGU, MoeSchedGU, false>(ring, S, E);
    }
    SEAM(19);
    if (IN(20)) {
        const int nlist = moe_tables(F, 1, TM, TP, CN, LST);
        MoeSchedDN S; S.lda = 1024; S.ldb = 1024; S.K = 512; S.TP = TP; S.CNT = CN; S.A = (const char*)WSP(bf16, WS_HBUF); S.B = (const char*)(WSP(bf16, WS_WD) + (size_t)NEX * 2048 * 512);
        S.rowidx = nullptr; S.LST = LST; S.nlist = nlist; S.nloc = (G - (bid & 7) + 7) >> 3; S.rank = bid >> 3; S.bstride = (size_t)2048 * 512 * 2;
        EpiMoeDN E{WSP(bf16, WS_YBUF)};
        pg8::gemm_phase<EpiMoeDN, MoeSchedDN, false>(ring, S, E);
    }
    SEAM(20);
    if (IN(21)) { (void)moe_tables(F, 1, TM, TP, CN, LST); combine_ln_phase(F, 1, TM, TP); }
    if (PROBE_STAMP >= 0) {
        if (PROBE_STAMP == NPHASE - 1) pst1 = __builtin_amdgcn_s_memrealtime();
        if (bid == 0) { const unsigned long long tgt = __builtin_amdgcn_s_memrealtime() + 9ull * (pst1 - pst0); while (__builtin_amdgcn_s_memrealtime() < tgt) __builtin_amdgcn_s_sleep(32); }
    }
#undef IN
#undef SEAM
}

#ifndef MK_CUTS
#define MK_CUTS 0
#endif
extern "C" void kernel_launch(void* const* d_in, const int* in_sizes, int n_in, void* d_out, int out_size, void* d_ws, size_t ws_size, hipStream_t stream) {
    static int grid = 0;
    if (grid == 0) {
        if (n_in != 31 || ws_size < WS_END) { fprintf(stderr, "kernel_launch: expected 31 inputs and >= %zu bytes of workspace (got %d, %zu)\n", (size_t)WS_END, n_in, ws_size); grid = -1; return; }
        int dev = 0, cus = 0, per_cu = 0;
        if (hipGetDevice(&dev) != hipSuccess || hipDeviceGetAttribute(&cus, hipDeviceAttributeMultiprocessorCount, dev) != hipSuccess) { grid = -1; return; }
        if (hipFuncSetAttribute((const void*)mk_fwd, hipFuncAttributeMaxDynamicSharedMemorySize, LDS_BYTES) != hipSuccess) { fprintf(stderr, "kernel_launch: hipFuncSetAttribute failed\n"); grid = -1; return; }
        if (hipOccupancyMaxActiveBlocksPerMultiprocessor(&per_cu, (const void*)mk_fwd, NTHR, LDS_BYTES) != hipSuccess || per_cu < 1) { fprintf(stderr, "kernel_launch: occupancy query says %d\n", per_cu); }
        (void)hipGetLastError();
        grid = cus;
    }
    if (grid < 0) return;
    (void)hipMemsetAsync((char*)d_ws + WS_CTL, 0, CTL_ZERO_BYTES, stream);
    Args a{};
    for (int i = 0; i < 31; ++i) a.in[i] = (const float*)d_in[i];
    a.out = (float*)d_out; a.ws = (unsigned char*)d_ws; a.pad = 0;
#if defined(PROBE_PHASE)
    { int li = 0;
      a.ph_lo = 0; a.ph_hi = PROBE_PHASE + 1; a.li = li++; hipLaunchKernelGGL(mk_fwd, dim3(grid), dim3(NTHR), LDS_BYTES, stream, a);
      if (PROBE_PHASE == 6 || PROBE_PHASE == 18) (void)hipMemsetAsync((char*)d_ws + WS_CTL + (size_t)CW_CNT * 4, 0, 65536, stream);
      a.ph_lo = PROBE_PHASE; a.ph_hi = PROBE_PHASE + 1; a.li = li++; hipLaunchKernelGGL(mk_fwd, dim3(grid), dim3(NTHR), LDS_BYTES, stream, a);
      if (PROBE_PHASE + 1 < NPHASE) { a.ph_lo = PROBE_PHASE + 1; a.ph_hi = NPHASE; a.li = li++; hipLaunchKernelGGL(mk_fwd, dim3(grid), dim3(NTHR), LDS_BYTES, stream, a); } }
#elif MK_CUTS == 0
    a.ph_lo = 0; a.ph_hi = NPHASE; a.li = 0;
    hipLaunchKernelGGL(mk_fwd, dim3(grid), dim3(NTHR), LDS_BYTES, stream, a);
#else
    for (int p = 0; p < NPHASE; ++p) { a.ph_lo = p; a.ph_hi = p + 1; a.li = 0; hipLaunchKernelGGL(mk_fwd, dim3(grid), dim3(NTHR), LDS_BYTES, stream, a); }
#endif
}
```
